# Optimizing an MI355X kernel written in HIP

```python
import math
import numpy as np
import jax, jax.numpy as jnp
from jax import lax

D_MODEL = 1024
BATCH = 2
SEQ = 16384
DEPTH = 2

N_MIXERS = 2
S5_GROUP = 16
S5_GROUPS = D_MODEL // S5_GROUP
S5_STATE = 64
HEAD_DIM = 64
N_HEADS = D_MODEL // HEAD_DIM
D_ATTN = N_HEADS * HEAD_DIM
DILATED_PAIRS = ((128, 1), (512, 4), (2048, 16))
N_DIL_GROUPS = len(DILATED_PAIRS)
ATTN_BLOCK = 128
N_BUCKETS = 32
MAX_DISTANCE = 2048
D_FF = ((8 * D_MODEL // 3 + 127) // 128) * 128
N_EXPERTS = 8
TOP_K = 2
D_FF_EXPERT = 7 * D_MODEL // 2
N_S5_LAYERS = (DEPTH + 1) // 2
N_ATTN_LAYERS = DEPTH // 2
DEEPNORM_ALPHA = (2 * DEPTH) ** 0.25
DEEPNORM_BETA = (8 * DEPTH) ** -0.25
LN_EPS = 1e-5
NEG_INF = -1e30

kernel_name = 'hybrid_s5_dilated_attn_moe_deepnorm'


def _layer_norm(x, g, b):
    xf = x.astype(jnp.float32)
    mu = jnp.mean(xf, axis=-1, keepdims=True)
    var = jnp.mean(jnp.square(xf - mu), axis=-1, keepdims=True)
    y = (xf - mu) * lax.rsqrt(var + LN_EPS)
    return (y * g.astype(jnp.float32) + b.astype(jnp.float32)).astype(x.dtype)


def _t5_bucket(dist):
    max_exact = N_BUCKETS // 2
    d = np.maximum(dist, 0)
    large = max_exact + (np.log(np.maximum(d, 1) / max_exact) / math.log(MAX_DISTANCE / max_exact)
                         * (N_BUCKETS - max_exact)).astype(np.int64)
    large = np.minimum(large, N_BUCKETS - 1)
    return np.where(d < max_exact, d, large).astype(np.int32)


def _s5_mixer(x, w_in, a_re, a_im, log_dt, b_re, b_im, c_re, c_im, d_skip, w_glu):
    f32 = jnp.float32
    bsz, seq, _ = x.shape
    u = (x @ w_in).reshape(bsz, seq, S5_GROUPS, S5_GROUP).astype(f32)
    dt = jnp.exp(log_dt.astype(f32))[:, None]
    lam_re = jnp.minimum(a_re.astype(f32), -1e-4)
    lam_im = a_im.astype(f32)
    mag = jnp.exp(lam_re * dt)
    ab_re = mag * jnp.cos(lam_im * dt)
    ab_im = mag * jnp.sin(lam_im * dt)
    den = lam_re * lam_re + lam_im * lam_im
    nr = ab_re - 1.0
    q_re = (nr * lam_re + ab_im * lam_im) / den
    q_im = (ab_im * lam_re - nr * lam_im) / den
    br, bi = b_re.astype(f32), b_im.astype(f32)
    bb_re = q_re[..., None] * br - q_im[..., None] * bi
    bb_im = q_re[..., None] * bi + q_im[..., None] * br
    bu_re = jnp.einsum('bsgc,gpc->bsgp', u, bb_re)
    bu_im = jnp.einsum('bsgc,gpc->bsgp', u, bb_im)
    a_re_t = jnp.broadcast_to(ab_re, bu_re.shape)
    a_im_t = jnp.broadcast_to(ab_im, bu_re.shape)

    def combine(e1, e2):
        a1r, a1i, b1r, b1i = e1
        a2r, a2i, b2r, b2i = e2
        return (a2r * a1r - a2i * a1i,
                a2r * a1i + a2i * a1r,
                a2r * b1r - a2i * b1i + b2r,
                a2r * b1i + a2i * b1r + b2i)

    _, _, h_re, h_im = lax.associative_scan(combine, (a_re_t, a_im_t, bu_re, bu_im), axis=1)
    y = (jnp.einsum('bsgp,gcp->bsgc', h_re, c_re.astype(f32))
         - jnp.einsum('bsgp,gcp->bsgc', h_im, c_im.astype(f32))
         + d_skip.astype(f32).reshape(S5_GROUPS, S5_GROUP) * u)
    y = y.reshape(bsz, seq, D_MODEL).astype(x.dtype)
    g = jax.nn.gelu(y)
    vg = g @ w_glu
    return vg[..., :D_MODEL] * jax.nn.sigmoid(vg[..., D_MODEL:])


def _dilated_branch(q, k, v, rel_bias, window, dilation):
    f32 = jnp.float32
    bsz, seq, nh, hd = q.shape
    span = window // dilation
    L = ATTN_BLOCK
    chunk = dilation * L
    sp = -(-seq // chunk) * chunk
    nb = sp // chunk

    def to_blocks(t):
        t = jnp.pad(t, ((0, 0), (0, sp - seq), (0, 0), (0, 0)))
        t = t.reshape(bsz, sp // dilation, dilation, nh, t.shape[-1]).transpose(0, 2, 1, 3, 4)
        return t.reshape(bsz, dilation, nb, L, nh, t.shape[-1])

    def from_blocks(t):
        t = t.reshape(bsz, dilation, sp // dilation, nh, t.shape[-1]).transpose(0, 2, 1, 3, 4)
        return t.reshape(bsz, sp, nh, t.shape[-1])[:, :seq]

    qb, kb, vb = to_blocks(q), to_blocks(k), to_blocks(v)
    def with_prev(t):
        prev = jnp.concatenate([jnp.zeros_like(t[:, :, :1]), t[:, :, :-1]], axis=2)
        return jnp.concatenate([prev, t], axis=3)
    kk, vv = with_prev(kb), with_prev(vb)

    qi = np.arange(L)[:, None]
    ki = np.arange(2 * L)[None, :]
    off = qi + L - ki
    band = (off >= 0) & (off <= span)
    mask = band[None] & ((np.arange(nb)[:, None, None] > 0) | (ki >= L)[None])
    bucket = _t5_bucket(np.clip(off, 0, None) * dilation)
    bias = jnp.transpose(rel_bias[bucket], (2, 0, 1)).astype(f32)

    logits = jnp.einsum('brnqhd,brnkhd->brnhqk', qb, kk).astype(f32) * (1.0 / math.sqrt(hd)) + bias
    logits = jnp.where(mask[None, None, :, None], logits, NEG_INF)
    m = jnp.max(logits, axis=-1, keepdims=True)
    p = jnp.exp(logits - m)
    s = jnp.sum(p, axis=-1, keepdims=True)
    o = jnp.einsum('brnhqk,brnkhd->brnqhd', p, vv.astype(f32)) / jnp.swapaxes(s, 3, 4)
    lse = jnp.swapaxes(m + jnp.log(s), 3, 4)
    return from_blocks(o), from_blocks(lse)[..., 0]


def _dilated_attention(x, w_qkv, w_o, rel_bias):
    bsz, seq, _ = x.shape
    qkv = (x @ w_qkv).reshape(bsz, seq, N_DIL_GROUPS, 3, N_HEADS, HEAD_DIM)
    outs, lses = [], []
    for g, (window, dilation) in enumerate(DILATED_PAIRS):
        o, lse = _dilated_branch(qkv[:, :, g, 0], qkv[:, :, g, 1], qkv[:, :, g, 2], rel_bias, window, dilation)
        outs.append(o)
        lses.append(lse)
    w = jax.nn.softmax(jnp.stack(lses, axis=0), axis=0)
    merged = jnp.einsum('gbsh,gbshd->bshd', w, jnp.stack(outs, axis=0))
    return merged.reshape(bsz, seq, D_ATTN).astype(x.dtype) @ w_o


def _swiglu(x, w1, w3, w2):
    return (jax.nn.silu(x @ w1) * (x @ w3)) @ w2


def _moe(x, w_router, w1, w3, w2):
    logits = (x @ w_router).astype(jnp.float32)
    top_v, top_i = lax.top_k(logits, TOP_K)
    gates = jax.nn.softmax(top_v, axis=-1)
    gate_full = jnp.sum(jax.nn.one_hot(top_i, N_EXPERTS, dtype=jnp.float32) * gates[..., None], axis=-2)
    out = jnp.zeros_like(x)
    for e in range(N_EXPERTS):
        y = _swiglu(x, w1[e], w3[e], w2[e])
        out = out + gate_full[..., e, None].astype(x.dtype) * y
    return out


def setup_inputs(seed: int = 0) -> dict:
    key = jax.random.key(seed)
    ks = jax.random.split(key, 24)
    f32 = jnp.float32

    def nrm(k, shape, scale):
        return jax.random.normal(k, shape, f32) * scale

    NS, NA = N_S5_LAYERS, N_ATTN_LAYERS
    x = nrm(ks[0], (BATCH, SEQ, D_MODEL), 1.0)
    s5_w_in = nrm(ks[1], (NS, D_MODEL, D_MODEL), D_MODEL ** -0.5)
    s5_a_re = -0.5 + nrm(ks[2], (NS, S5_GROUPS, S5_STATE), 0.01)
    s5_a_im = math.pi * jnp.arange(S5_STATE, dtype=f32) + nrm(ks[3], (NS, S5_GROUPS, S5_STATE), 0.01)
    s5_log_dt = jax.random.uniform(ks[4], (NS, S5_GROUPS), f32, math.log(1e-3), math.log(1e-1))
    s5_b_re = nrm(ks[5], (NS, S5_GROUPS, S5_STATE, S5_GROUP), (2 * S5_GROUP) ** -0.5)
    s5_b_im = nrm(ks[6], (NS, S5_GROUPS, S5_STATE, S5_GROUP), (2 * S5_GROUP) ** -0.5)
    s5_c_re = nrm(ks[7], (NS, S5_GROUPS, S5_GROUP, S5_STATE), (2 * S5_STATE) ** -0.5)
    s5_c_im = nrm(ks[8], (NS, S5_GROUPS, S5_GROUP, S5_STATE), (2 * S5_STATE) ** -0.5)
    s5_d = nrm(ks[9], (NS, D_MODEL), 1.0)
    glu_scale = jnp.concatenate([jnp.full((D_MODEL,), DEEPNORM_BETA, f32), jnp.ones((D_MODEL,), f32)])
    s5_w_glu = nrm(ks[10], (NS, D_MODEL, 2 * D_MODEL), D_MODEL ** -0.5) * glu_scale
    qkv_scale = jnp.array([1.0, 1.0, DEEPNORM_BETA], f32)[:, None]
    attn_w_qkv = (nrm(ks[11], (NA, D_MODEL, N_DIL_GROUPS, 3, D_ATTN), D_MODEL ** -0.5)
                  * qkv_scale).reshape(NA, D_MODEL, N_DIL_GROUPS * 3 * D_ATTN)
    attn_w_o = nrm(ks[12], (NA, D_ATTN, D_MODEL), D_ATTN ** -0.5 * DEEPNORM_BETA)
    rel_bias = nrm(ks[13], (N_BUCKETS, N_HEADS), 0.5)
    ffn_w1 = nrm(ks[14], (NS, D_MODEL, D_FF), D_MODEL ** -0.5)
    ffn_w3 = nrm(ks[15], (NS, D_MODEL, D_FF), D_MODEL ** -0.5)
    ffn_w2 = nrm(ks[16], (NS, D_FF, D_MODEL), D_FF ** -0.5 * DEEPNORM_BETA)
    moe_w_router = nrm(ks[17], (NA, D_MODEL, N_EXPERTS), D_MODEL ** -0.5)
    moe_w1 = nrm(ks[18], (NA, N_EXPERTS, D_MODEL, D_FF_EXPERT), D_MODEL ** -0.5)
    moe_w3 = nrm(ks[19], (NA, N_EXPERTS, D_MODEL, D_FF_EXPERT), D_MODEL ** -0.5)
    moe_w2 = nrm(ks[20], (NA, N_EXPERTS, D_FF_EXPERT, D_MODEL), D_FF_EXPERT ** -0.5 * DEEPNORM_BETA)
    ln_g = 1.0 + nrm(ks[21], (DEPTH, 2, D_MODEL), 0.02)
    ln_b = nrm(ks[22], (DEPTH, 2, D_MODEL), 0.02)
    return {'x': x, 's5_w_in': s5_w_in, 's5_a_re': s5_a_re, 's5_a_im': s5_a_im, 's5_log_dt': s5_log_dt,
            's5_b_re': s5_b_re, 's5_b_im': s5_b_im, 's5_c_re': s5_c_re, 's5_c_im': s5_c_im, 's5_d': s5_d,
            's5_w_glu': s5_w_glu, 'attn_w_qkv': attn_w_qkv, 'attn_w_o': attn_w_o, 'rel_bias': rel_bias,
            'ffn_w1': ffn_w1, 'ffn_w3': ffn_w3, 'ffn_w2': ffn_w2, 'moe_w_router': moe_w_router,
            'moe_w1': moe_w1, 'moe_w3': moe_w3, 'moe_w2': moe_w2, 'ln_g': ln_g, 'ln_b': ln_b}


def reference(x, s5_w_in, s5_a_re, s5_a_im, s5_log_dt, s5_b_re, s5_b_im, s5_c_re, s5_c_im, s5_d,
              s5_w_glu, attn_w_qkv, attn_w_o, rel_bias, ffn_w1, ffn_w3, ffn_w2, moe_w_router,
              moe_w1, moe_w3, moe_w2, ln_g, ln_b):
    for i in range(DEPTH):
        j = i // N_MIXERS
        if i % N_MIXERS == 0:
            h = _s5_mixer(x, s5_w_in[j], s5_a_re[j], s5_a_im[j], s5_log_dt[j], s5_b_re[j], s5_b_im[j],
                          s5_c_re[j], s5_c_im[j], s5_d[j], s5_w_glu[j])
            x = _layer_norm(DEEPNORM_ALPHA * x + h, ln_g[i, 0], ln_b[i, 0])
            f = _swiglu(x, ffn_w1[j], ffn_w3[j], ffn_w2[j])
        else:
            h = _dilated_attention(x, attn_w_qkv[j], attn_w_o[j], rel_bias)
            x = _layer_norm(DEEPNORM_ALPHA * x + h, ln_g[i, 0], ln_b[i, 0])
            f = _moe(x, moe_w_router[j], moe_w1[j], moe_w3[j], moe_w2[j])
        x = _layer_norm(DEEPNORM_ALPHA * x + f, ln_g[i, 1], ln_b[i, 1])
    return x
```

```cpp
#include <hip/hip_runtime.h>
#include <cstdio>
#include <cstdint>
#include <cmath>

#ifndef FFN_DOWN_FP8
#define FFN_DOWN_FP8 1
#endif
#ifndef MK_SPLIT
#define MK_SPLIT 0
#endif

namespace pg8 {
#define PG8_LAS __attribute__((address_space(3)))
typedef unsigned short bf16_t;
typedef short bf16x8 __attribute__((ext_vector_type(8)));
typedef float f32x4 __attribute__((ext_vector_type(4)));
typedef float f32x2 __attribute__((ext_vector_type(2)));
typedef unsigned u32x4 __attribute__((ext_vector_type(4)));
typedef unsigned u32x2 __attribute__((ext_vector_type(2)));
constexpr int BM = 256, BK = 64, HALF = 128, HTB = HALF * BK * 2, STAGE_BYTES = 8 * HTB, NXCD = 8, WGM = 8;

__host__ __device__ __forceinline__ int lds_byte(int r, int c) { const int st = (r >> 4) * 2 + (c >> 5), rr = r & 15, cc = c & 31, ob = rr * 64 + cc * 2; return st * 1024 + (ob ^ (((ob >> 9) & 1) << 5)); }
__host__ __device__ __forceinline__ void stage_rc(int b, int& R, int& C) { const int st = b / 1024, sb = b % 1024, swz = sb ^ (((sb >> 9) & 1) << 5); R = (st >> 1) * 16 + swz / 64; C = (st & 1) * 32 + (swz % 64) / 2; }
__host__ __device__ __forceinline__ int perm32(int rho) { const int n = rho >> 4, i = rho & 15; return 8 * (i >> 2) + 4 * n + (i & 3); }

struct Unit { int pm, pn, kc; };
struct Gemm { const bf16_t* A; const bf16_t* Bt; int M, N, K; };

struct StaticOrder {
    int nM, nN, nwg, G, c;
    __host__ __device__ void init(int M, int N, int G_, int c_) { nM = M / BM; nN = N / BM; nwg = nM * nN; G = G_; c = c_; }
    __host__ __device__ bool next(int i, Unit& u) const {
        const long L = (long)i * G + c; if (L >= nwg) return false;
        int wgid = (int)L; { const int q = nwg / NXCD, r = nwg % NXCD, xcd = wgid % NXCD, off = wgid / NXCD; wgid = (xcd < r ? xcd * (q + 1) : r * (q + 1) + (xcd - r) * q) + off; }
        const int nig = WGM * nN, gid = wgid / nig, fm = gid * WGM, gsz = (nM - fm) < WGM ? (nM - fm) : WGM;
        u.pm = fm + ((wgid % nig) % gsz); u.pn = (wgid % nig) / gsz; u.kc = 0; return true;
    }
    __device__ __forceinline__ void a_ready(const Unit&) const {}
    __device__ __forceinline__ void done(const Unit&) const {}
};

struct ListOrder {
    const PG8_LAS unsigned* list; int n;
    __device__ __forceinline__ bool next(int i, Unit& u) const { if (i >= n) return false; const unsigned w = (unsigned)__builtin_amdgcn_readfirstlane((int)list[i]); u.pm = (int)(w & 0xffffu); u.pn = (int)((w >> 16) & 0xffu); u.kc = (int)(w >> 24); return true; }
    __device__ __forceinline__ void a_ready(const Unit&) const {}
    __device__ __forceinline__ void done(const Unit&) const {}
};
__device__ __forceinline__ unsigned grouped_unit(const int (&tp)[9], int lo, int hi, int nN, long L) {
    const int ntot = (hi - lo) * nN;
    int w = (int)L; { const int q = ntot / NXCD, r = ntot % NXCD, xcd = w % NXCD, off = w / NXCD; w = (xcd < r ? xcd * (q + 1) : r * (q + 1) + (xcd - r) * q) + off; }
    int s_lo = 0, s_nt = 1, s_e = 0; bool found = false;
#pragma unroll
    for (int e = 0; e < 8; ++e) { const int a = tp[e], b = tp[e + 1]; const int l_ = a > lo ? a : lo, h_ = b < hi ? b : hi; const int nt_ = h_ > l_ ? h_ - l_ : 0; const int nu_ = nt_ * nN;
        if (!found) { if (w < nu_) { found = true; s_lo = l_; s_nt = nt_; s_e = e; } else w -= nu_; } }
    const int nig = WGM * nN, gid = w / nig, fm = gid * WGM, gsz = (s_nt - fm) < WGM ? (s_nt - fm) : WGM;
    const int pm = s_lo - lo + fm + ((w % nig) % gsz), pn = s_e * nN + (w % nig) / gsz;
    return (unsigned)pm | ((unsigned)pn << 16);
}

typedef __bf16 bf16x2_t __attribute__((ext_vector_type(2)));
__device__ __forceinline__ unsigned cvt_pk_bf16(float lo, float hi) { f32x2 v = {lo, hi}; bf16x2_t b = __builtin_convertvector(v, bf16x2_t); return __builtin_bit_cast(unsigned, b); }
__device__ __forceinline__ float clamp8(float x) { return __builtin_amdgcn_fmed3f(x, -440.f, 440.f); }
__device__ __forceinline__ unsigned pk4_fp8(float a, float b, float c, float d) { int r = __builtin_amdgcn_cvt_pk_fp8_f32(clamp8(a), clamp8(b), 0, false); r = __builtin_amdgcn_cvt_pk_fp8_f32(clamp8(c), clamp8(d), r, true); return (unsigned)r; }
__device__ __forceinline__ float bf_lo(unsigned w) { return __uint_as_float(w << 16); }
__device__ __forceinline__ float bf_hi(unsigned w) { return __uint_as_float(w & 0xffff0000u); }
__device__ __forceinline__ float sigmoidf_fast(float x) { return __builtin_amdgcn_rcpf(1.0f + __builtin_amdgcn_exp2f(-1.4426950408889634f * x)); }
typedef long long stat_t;
__device__ __forceinline__ void row_stats(const stat_t* ST, int row, float& mean, float& rstd) {
    const stat_t w = ST[row]; const float fs = (float)(int)(w >> 32) * (1.0f / 65536.0f), fq2 = (float)(unsigned)(w & 0xffffffffll) * (1.0f / 4096.0f);
    mean = fs * (1.0f / 1024.0f); const float var = fmaxf(fq2 * (1.0f / 1024.0f) - mean * mean, 0.f); rstd = __builtin_amdgcn_rsqf(var + 1e-5f);
}
__device__ __forceinline__ void add_row_stats4(stat_t* ST, int rowb, int fr, int fq, const float (&s)[4], const float (&q)[4]) {
    float ts = 0.f, tq = 0.f;
#pragma unroll
    for (int m = 0; m < 4; ++m) { float a = s[m], b = q[m]; a += __shfl_xor(a, 16); a += __shfl_xor(a, 32); b += __shfl_xor(b, 16); b += __shfl_xor(b, 32); if (fq == m) { ts = a; tq = b; } }
    const stat_t w = (stat_t)((unsigned long long)(unsigned)__float2int_rn(ts * 65536.0f) << 32) + (stat_t)(unsigned)__float2uint_rn(tq * 4096.0f);
    atomicAdd((unsigned long long*)(ST + rowb + 16 * fq + fr), (unsigned long long)w);
}

struct EpiQKV {
    static constexpr bool PERM = true, AFTER_DRAIN = false;
    bf16_t* O; size_t stride; float sc; const stat_t* ST; const float* cv; const float* dv; int ldil;
    __device__ __forceinline__ void operator()(const f32x4 (&acc)[2][2][4][2], const Unit& u, int wr, int wc, int fr, int fq) const {
        const int row0 = u.pm * BM + wr * 64 + fr; const int t = u.pn >> 2;
        bf16_t* base = O + (size_t)t * stride + (wc & 1) * 32 + 8 * fq;
        const int hd0 = (u.pn & 3) * 4 + (wc >> 1);
        f32x4 cc[2][2], dd[2][2];
#pragma unroll
        for (int bj = 0; bj < 2; ++bj)
#pragma unroll
            for (int n = 0; n < 2; ++n) { cc[bj][n] = *(const f32x4*)(cv + u.pn * BM + bj * HALF + wc * 32 + 8 * fq + 4 * n); dd[bj][n] = *(const f32x4*)(dv + u.pn * BM + bj * HALF + wc * 32 + 8 * fq + 4 * n); }
#pragma unroll
        for (int ai = 0; ai < 2; ++ai)
#pragma unroll
            for (int m = 0; m < 4; ++m) { const int row = row0 + ai * HALF + m * 16; const int bb = row >> 14, tok = row & 16383;
                const size_t rn = (size_t)(tok & ((1 << ldil) - 1)) * (16384 >> ldil) + (tok >> ldil);
                float mean, rstd; row_stats(ST, row, mean, rstd);
#pragma unroll
                for (int bj = 0; bj < 2; ++bj) { f32x4 v0 = (acc[ai][bj][m][0] * sc - cc[bj][0] * mean) * rstd + dd[bj][0], v1 = (acc[ai][bj][m][1] * sc - cc[bj][1] * mean) * rstd + dd[bj][1];
                    const size_t rowi = (size_t)(bb * 16 + hd0 + bj * 2) * 16384 + rn;
                    if (t < 3) {
                        const float s8 = t == 0 ? 8.f : t == 1 ? 0.125f : 16.f; v0 = v0 * s8; v1 = v1 * s8; u32x2 q8; q8.x = pk4_fp8(v0[0], v0[1], v0[2], v0[3]); q8.y = pk4_fp8(v1[0], v1[1], v1[2], v1[3]);
                        const int c8 = (wc & 1) * 4 + fq, p8 = t == 2 ? c8 : (c8 & 1) * 4 + (c8 >> 1), sw = t == 1 ? (int)((tok >> ldil) >> 2) & 3 : 0;
                        *(u32x2*)((unsigned char*)O + (size_t)t * stride * 2 + rowi * 64 + (((p8 >> 1) ^ sw) << 4) + ((p8 & 1) << 3)) = q8;
                    } else {
                        u32x4 w; w.x = cvt_pk_bf16(v0[0], v0[1]); w.y = cvt_pk_bf16(v0[2], v0[3]); w.z = cvt_pk_bf16(v1[0], v1[1]); w.w = cvt_pk_bf16(v1[2], v1[3]);
                        *(u32x4*)(base + rowi * 64) = w; } } }
    }
};
struct EpiU {
    static constexpr bool PERM = true, AFTER_DRAIN = false;
    bf16_t* U; float sc;
    __device__ __forceinline__ void operator()(const f32x4 (&acc)[2][2][4][2], const Unit& u, int wr, int wc, int fr, int fq) const {
        const int row0 = u.pm * BM + wr * 64 + fr; const int col0 = u.pn * BM + wc * 32 + 8 * fq;
#pragma unroll
        for (int ai = 0; ai < 2; ++ai)
#pragma unroll
            for (int m = 0; m < 4; ++m) { const int row = row0 + ai * HALF + m * 16; const int b = row >> 14, t = row & 16383;
#pragma unroll
                for (int bj = 0; bj < 2; ++bj) { const int col = col0 + bj * HALF; const int g = col >> 4, c = col & 15;
                    const f32x4 v0 = acc[ai][bj][m][0] * sc, v1 = acc[ai][bj][m][1] * sc;
                    u32x4 w; w.x = cvt_pk_bf16(v0[0], v0[1]); w.y = cvt_pk_bf16(v0[2], v0[3]); w.z = cvt_pk_bf16(v1[0], v1[1]); w.w = cvt_pk_bf16(v1[2], v1[3]);
                    *(u32x4*)(U + (((size_t)(b * 64 + g) * 16384 + t) * 16 + c)) = w; } }
    }
};
struct EpiGLU {
    static constexpr bool PERM = true, AFTER_DRAIN = false;
    const float* X; bf16_t* Z; float alpha; float gain; float sc; stat_t* ST;
    __device__ __forceinline__ void operator()(const f32x4 (&acc)[2][2][4][2], const Unit& u, int wr, int wc, int fr, int fq) const {
        const int row0 = u.pm * BM + wr * 64 + fr; const int col0 = u.pn * HALF + wc * 32 + 8 * fq;
#pragma unroll
        for (int ai = 0; ai < 2; ++ai) { float s4[4], q4[4];
#pragma unroll
            for (int m = 0; m < 4; ++m) { const size_t off = (size_t)(row0 + ai * HALF + m * 16) * 1024 + col0; float z[8]; float ssum = 0.f, ssq = 0.f;
#pragma unroll
                for (int n = 0; n < 2; ++n) { const f32x4 v = acc[ai][0][m][n] * sc, gt = acc[ai][1][m][n] * sc; const f32x4 x = *(const f32x4*)(X + off + 4 * n);
#pragma unroll
                    for (int i = 0; i < 4; ++i) { const float zz = alpha * x[i] + gain * (v[i] * sigmoidf_fast(gt[i])); z[4 * n + i] = zz; ssum += zz; ssq += zz * zz; } }
                s4[m] = ssum; q4[m] = ssq;
                u32x4 w; w.x = cvt_pk_bf16(z[0], z[1]); w.y = cvt_pk_bf16(z[2], z[3]); w.z = cvt_pk_bf16(z[4], z[5]); w.w = cvt_pk_bf16(z[6], z[7]);
                *(u32x4*)(Z + off) = w; }
            add_row_stats4(ST, u.pm * BM + wr * 64 + ai * HALF, fr, fq, s4, q4); }
    }
};
struct EpiSwiGLU {
    static constexpr bool PERM = true, AFTER_DRAIN = false;
    bf16_t* H; int ldh; int ntn;
    __device__ __forceinline__ void operator()(const f32x4 (&acc)[2][2][4][2], const Unit& u, int wr, int wc, int fr, int fq) const {
        const int row0 = u.pm * BM + wr * 64 + fr; const int col0 = (u.pn % ntn) * HALF + wc * 32 + 8 * fq;
#pragma unroll
        for (int ai = 0; ai < 2; ++ai)
#pragma unroll
            for (int m = 0; m < 4; ++m) { bf16_t* p = H + (size_t)(row0 + ai * HALF + m * 16) * ldh + col0;
                float h[8];
#pragma unroll
                for (int n = 0; n < 2; ++n) { const f32x4 a = acc[ai][0][m][n], b = acc[ai][1][m][n];
#pragma unroll
                    for (int i = 0; i < 4; ++i) h[4 * n + i] = a[i] * sigmoidf_fast(a[i]) * b[i]; }
                u32x4 w; w.x = cvt_pk_bf16(h[0], h[1]); w.y = cvt_pk_bf16(h[2], h[3]); w.z = cvt_pk_bf16(h[4], h[5]); w.w = cvt_pk_bf16(h[6], h[7]);
                *(u32x4*)p = w; }
    }
};
struct EpiSwiGLU8 {
    static constexpr bool PERM = true, AFTER_DRAIN = false;
    unsigned char* H; int ldh; int ntn; float sin, sout;
    __device__ __forceinline__ void operator()(const f32x4 (&acc)[2][2][4][2], const Unit& u, int wr, int wc, int fr, int fq) const {
        const int row0 = u.pm * BM + wr * 64 + fr; const int col0 = (u.pn % ntn) * HALF + wc * 32 + 8 * fq;
#pragma unroll
        for (int ai = 0; ai < 2; ++ai)
#pragma unroll
            for (int m = 0; m < 4; ++m) { unsigned char* p = H + (size_t)(row0 + ai * HALF + m * 16) * ldh + col0;
                float h[8];
#pragma unroll
                for (int n = 0; n < 2; ++n) { const f32x4 a = acc[ai][0][m][n], b = acc[ai][1][m][n];
#pragma unroll
                    for (int i = 0; i < 4; ++i) h[4 * n + i] = a[i] * b[i] * (sin * sin * sout) * __builtin_amdgcn_rcpf(1.0f + __builtin_amdgcn_exp2f(a[i] * (-1.4426950408889634f * sin))); }
                u32x2 w; w.x = pk4_fp8(h[0], h[1], h[2], h[3]); w.y = pk4_fp8(h[4], h[5], h[6], h[7]);
                *(u32x2*)p = w; }
    }
};
struct EpiResid {
    static constexpr bool PERM = false, AFTER_DRAIN = false;
    const bf16_t* XB; bf16_t* Z; float alpha; float gain;
    __device__ __forceinline__ void operator()(const f32x4 (&acc)[2][2][4][2], const Unit& u, int wr, int wc, int fr, int fq) const {
        const int row0 = u.pm * BM + wr * 64 + fr; const int col0 = u.pn * BM + wc * 32 + 4 * fq;
#pragma unroll
        for (int ai = 0; ai < 2; ++ai)
#pragma unroll
            for (int m = 0; m < 4; ++m) { const size_t off = (size_t)(row0 + ai * HALF + m * 16) * 1024 + col0;
#pragma unroll
                for (int bj = 0; bj < 2; ++bj)
#pragma unroll
                    for (int n = 0; n < 2; ++n) { const u32x2 xw = *(const u32x2*)(XB + off + bj * HALF + n * 16); const f32x4 a = acc[ai][bj][m][n];
                        u32x2 z; z.x = cvt_pk_bf16(alpha * bf_lo(xw.x) + gain * a[0], alpha * bf_hi(xw.x) + gain * a[1]); z.y = cvt_pk_bf16(alpha * bf_lo(xw.y) + gain * a[2], alpha * bf_hi(xw.y) + gain * a[3]);
                        *(u32x2*)(Z + off + bj * HALF + n * 16) = z; } }
    }
};
template <bool OUT8> struct EpiSwiGLUf {
    static constexpr bool PERM = true, AFTER_DRAIN = false;
    bf16_t* H; int ldh; const stat_t* ST; const float* cv; const float* dv;
    __device__ __forceinline__ void operator()(const f32x4 (&acc)[2][2][4][2], const Unit& u, int wr, int wc, int fr, int fq) const {
        const int row0 = u.pm * BM + wr * 64 + fr; const int jc = wc * 32 + 8 * fq; const int col0 = u.pn * HALF + jc;
        f32x4 ca[2], cb[2], da[2], db[2];
#pragma unroll
        for (int n = 0; n < 2; ++n) { ca[n] = *(const f32x4*)(cv + u.pn * BM + jc + 4 * n); cb[n] = *(const f32x4*)(cv + u.pn * BM + HALF + jc + 4 * n);
            da[n] = *(const f32x4*)(dv + u.pn * BM + jc + 4 * n); db[n] = *(const f32x4*)(dv + u.pn * BM + HALF + jc + 4 * n); }
#pragma unroll
        for (int ai = 0; ai < 2; ++ai)
#pragma unroll
            for (int m = 0; m < 4; ++m) { const int row = row0 + ai * HALF + m * 16; float mean, rstd; row_stats(ST, row, mean, rstd);
                float h[8];
#pragma unroll
                for (int n = 0; n < 2; ++n) { const f32x4 a = (acc[ai][0][m][n] - ca[n] * mean) * rstd + da[n], b = (acc[ai][1][m][n] - cb[n] * mean) * rstd + db[n];
#pragma unroll
                    for (int i = 0; i < 4; ++i) h[4 * n + i] = a[i] * sigmoidf_fast(a[i]) * b[i]; }
                if constexpr (OUT8) { u32x2 w8; w8.x = pk4_fp8(h[0] * 8.f, h[1] * 8.f, h[2] * 8.f, h[3] * 8.f); w8.y = pk4_fp8(h[4] * 8.f, h[5] * 8.f, h[6] * 8.f, h[7] * 8.f); *(u32x2*)((unsigned char*)H + (size_t)row * ldh + col0) = w8; }
                else { u32x4 w; w.x = cvt_pk_bf16(h[0], h[1]); w.y = cvt_pk_bf16(h[2], h[3]); w.z = cvt_pk_bf16(h[4], h[5]); w.w = cvt_pk_bf16(h[6], h[7]);
                    *(u32x4*)(H + (size_t)row * ldh + col0) = w; } }
    }
};
struct EpiResidF {
    static constexpr bool PERM = true, AFTER_DRAIN = false;
    const bf16_t* Zin; const stat_t* STin; const float* gam; const float* bet; bf16_t* Zout; unsigned char* Zq; stat_t* STout; float alpha; float gain;
    __device__ __forceinline__ void operator()(const f32x4 (&acc)[2][2][4][2], const Unit& u, int wr, int wc, int fr, int fq) const {
        const int row0 = u.pm * BM + wr * 64 + fr; const int col0 = u.pn * BM + wc * 32 + 8 * fq;
        f32x4 g[2][2], bb[2][2];
#pragma unroll
        for (int bj = 0; bj < 2; ++bj)
#pragma unroll
            for (int n = 0; n < 2; ++n) { g[bj][n] = *(const f32x4*)(gam + col0 + bj * HALF + 4 * n); bb[bj][n] = *(const f32x4*)(bet + col0 + bj * HALF + 4 * n); }
#pragma unroll
        for (int ai = 0; ai < 2; ++ai) { float s4[4], q4[4];
#pragma unroll
            for (int m = 0; m < 4; ++m) { const int row = row0 + ai * HALF + m * 16; const size_t off = (size_t)row * 1024 + col0; float mean, rstd; row_stats(STin, row, mean, rstd);
                float ssum = 0.f, ssq = 0.f;
#pragma unroll
                for (int bj = 0; bj < 2; ++bj) { const u32x4 zw = *(const u32x4*)(Zin + off + bj * HALF); float zo[8];
#pragma unroll
                    for (int n = 0; n < 2; ++n) { const f32x4 a = acc[ai][bj][m][n]; const unsigned w0 = zw[2 * n], w1 = zw[2 * n + 1];
                        const f32x4 zi = {bf_lo(w0), bf_hi(w0), bf_lo(w1), bf_hi(w1)};
                        const f32x4 x = (zi - mean) * rstd * g[bj][n] + bb[bj][n]; const f32x4 z = x * alpha + a * gain;
#pragma unroll
                        for (int i = 0; i < 4; ++i) { zo[4 * n + i] = z[i]; ssum += z[i]; ssq += z[i] * z[i]; } }
                    u32x4 w; w.x = cvt_pk_bf16(zo[0], zo[1]); w.y = cvt_pk_bf16(zo[2], zo[3]); w.z = cvt_pk_bf16(zo[4], zo[5]); w.w = cvt_pk_bf16(zo[6], zo[7]);
                    *(u32x4*)(Zout + off + bj * HALF) = w;
                    if (Zq) { u32x2 q8; q8.x = pk4_fp8(zo[0] * 16.f, zo[1] * 16.f, zo[2] * 16.f, zo[3] * 16.f); q8.y = pk4_fp8(zo[4] * 16.f, zo[5] * 16.f, zo[6] * 16.f, zo[7] * 16.f); *(u32x2*)(Zq + off + bj * HALF) = q8; } }
                s4[m] = ssum; q4[m] = ssq; }
            if (STout) add_row_stats4(STout, u.pm * BM + wr * 64 + ai * HALF, fr, fq, s4, q4); }
    }
};
struct EpiMoE2 {
    static constexpr bool PERM = true, AFTER_DRAIN = false;
    bf16_t* Y; const int* slot_tok; int ntn; float sc; bf16_t* PART;
    __device__ __forceinline__ void operator()(const f32x4 (&acc)[2][2][4][2], const Unit& u, int wr, int wc, int fr, int fq) const {
        if (u.kc) {
            bf16_t* tile = PART + ((size_t)(((u.pm - 256) * 4 + (u.pn % ntn)) * 7 + (u.kc - 1)) << 16) + (size_t)(wr * 64 + fr) * 256 + wc * 32 + 8 * fq;
#pragma unroll
            for (int ai = 0; ai < 2; ++ai)
#pragma unroll
                for (int m = 0; m < 4; ++m)
#pragma unroll
                    for (int bj = 0; bj < 2; ++bj) { const f32x4 v0 = acc[ai][bj][m][0] * sc, v1 = acc[ai][bj][m][1] * sc;
                        u32x4 w; w.x = cvt_pk_bf16(v0[0], v0[1]); w.y = cvt_pk_bf16(v0[2], v0[3]); w.z = cvt_pk_bf16(v1[0], v1[1]); w.w = cvt_pk_bf16(v1[2], v1[3]);
                        *(u32x4*)(tile + (size_t)(ai * HALF + m * 16) * 256 + bj * HALF) = w; }
            return; }
        const int row0 = u.pm * BM + wr * 64 + fr; const int col0 = (u.pn % ntn) * BM + wc * 32 + 8 * fq;
#pragma unroll
        for (int ai = 0; ai < 2; ++ai)
#pragma unroll
            for (int m = 0; m < 4; ++m) { const int st = slot_tok[row0 + ai * HALF + m * 16];
                if (st >= 0) { bf16_t* rowp = Y + (size_t)st * 1024 + col0;
#pragma unroll
                    for (int bj = 0; bj < 2; ++bj) { const f32x4 v0 = acc[ai][bj][m][0] * sc, v1 = acc[ai][bj][m][1] * sc;
                        u32x4 w; w.x = cvt_pk_bf16(v0[0], v0[1]); w.y = cvt_pk_bf16(v0[2], v0[3]); w.z = cvt_pk_bf16(v1[0], v1[1]); w.w = cvt_pk_bf16(v1[2], v1[3]);
                        *(u32x4*)(rowp + bj * HALF) = w; } } }
    }
};

typedef int i32x8 __attribute__((ext_vector_type(8)));
template <class Epi, class Sched, bool ALIGN_EPI = false, bool SP2 = false, bool FP8 = false, int KCH_T = 0>
__device__ __forceinline__ void gemm_phase(PG8_LAS unsigned char* lds, const Gemm g, const Sched& S, const Epi& E) {
    const int tid = threadIdx.x, wid = __builtin_amdgcn_readfirstlane(tid >> 6), lane = tid & 63, wr = wid >> 2, wc = wid & 3, fr = lane & 15, fq = lane >> 4;
    const int K = g.K, nt = K / BK;
    unsigned voffA[2], voffB[2];
#pragma unroll
    for (int i = 0; i < 2; ++i) { int R, C; stage_rc(tid * 16 + i * 8192, R, C); const int Rb = Epi::PERM ? ((R & ~31) + perm32(R & 31)) : R;
        voffA[i] = (unsigned)(R * K + C) * 2u; voffB[i] = (unsigned)(Rb * K + C) * 2u; }
    const size_t kstep = (size_t)(BK * 2);
    const size_t hstep = (size_t)HALF * K * 2;
    const size_t tstep = 2 * hstep;
    const unsigned ldsw = (unsigned)wid * 1024u;
    const int aoff = lds_byte(wr * 64 + fr, fq * 8), boff = lds_byte(wc * 32 + fr, fq * 8);
#define PG8_SA(b, h) (((b) * 2 + (h)) * HTB)
#define PG8_SB(b, h) ((4 + (b) * 2 + (h)) * HTB)
#define PG8_STAGE(bufoff, gbase, voff) do { _Pragma("unroll") for (int _i = 0; _i < 2; ++_i) \
        __builtin_amdgcn_global_load_lds((const unsigned*)((const char*)(gbase) + (voff)[_i]), (PG8_LAS unsigned*)(lds + (bufoff) + ldsw + _i * 8192), 16, 0, 0); } while (0)
#define PG8_LDA(dst, b, h) do { _Pragma("unroll") for (int m = 0; m < 4; ++m) _Pragma("unroll") for (int k = 0; k < 2; ++k) dst[m][k] = *(const PG8_LAS bf16x8*)(lds + PG8_SA(b, h) + aoff + m * 2048 + k * 1024); } while (0)
#define PG8_LDB(dst, b, h) do { _Pragma("unroll") for (int n = 0; n < 2; ++n) _Pragma("unroll") for (int k = 0; k < 2; ++k) dst[n][k] = *(const PG8_LAS bf16x8*)(lds + PG8_SB(b, h) + boff + n * 2048 + k * 1024); } while (0)
#define PG8_CAT(x) __builtin_shufflevector(__builtin_bit_cast(u32x4, (x)[0]), __builtin_bit_cast(u32x4, (x)[1]), 0, 1, 2, 3, 4, 5, 6, 7)
#define PG8_MMA(ai, bj, At, Bt) do { __builtin_amdgcn_s_setprio(1); _Pragma("unroll") for (int m = 0; m < 4; ++m) _Pragma("unroll") for (int n = 0; n < 2; ++n) { \
        if constexpr (FP8) { const i32x8 b8_ = __builtin_bit_cast(i32x8, PG8_CAT(Bt[n])), a8_ = __builtin_bit_cast(i32x8, PG8_CAT(At[m])); \
            asm volatile("v_mfma_scale_f32_16x16x128_f8f6f4 %0, %1, %2, %0, %3, %3 op_sel_hi:[0,0,0]" : "+v"(acc[ai][bj][m][n]) : "v"(b8_), "v"(a8_), "v"(sc127)); } \
        else { _Pragma("unroll") for (int k = 0; k < 2; ++k) acc[ai][bj][m][n] = __builtin_amdgcn_mfma_f32_16x16x32_bf16(Bt[n][k], At[m][k], acc[ai][bj][m][n], 0, 0, 0); } } \
        __builtin_amdgcn_s_setprio(0); } while (0)
#define PG8_WAIT_V(n) asm volatile("s_waitcnt vmcnt(" #n ")" ::: "memory")
#define PG8_WAIT_L(n) asm volatile("s_waitcnt lgkmcnt(" #n ")" ::: "memory")
#define PG8_BAR __builtin_amdgcn_s_barrier()
#define PG8_SCHED __builtin_amdgcn_sched_barrier(0)
    Unit cur, nxt; int ui = 0;
    if (!S.next(0, cur)) return;
    int sc127 = 127; asm volatile("" : "+v"(sc127));
    f32x4 acc[2][2][4][2];
#pragma unroll
    for (int a = 0; a < 2; ++a)
#pragma unroll
        for (int b = 0; b < 2; ++b)
#pragma unroll
            for (int m = 0; m < 4; ++m)
#pragma unroll
                for (int n = 0; n < 2; ++n) { acc[a][b][m][n] = (f32x4){0.f, 0.f, 0.f, 0.f}; }
    bf16x8 At[4][2], B0[2][2], B1[2][2];
    const char* cA = (const char*)g.A + (size_t)cur.pm * tstep; const char* cB = (const char*)g.Bt + (size_t)cur.pn * tstep;
    int ntu = nt;
    if constexpr (KCH_T > 0) { if (cur.kc) { const size_t ko = (size_t)(cur.kc - 1) * KCH_T * kstep; cA += ko; cB += ko; ntu = KCH_T; } }
    S.a_ready(cur);
    if constexpr (SP2) {
        PG8_STAGE(PG8_SB(0, 0), cB, voffB); PG8_STAGE(PG8_SB(0, 1), cB + hstep, voffB); PG8_STAGE(PG8_SA(0, 0), cA, voffA); PG8_STAGE(PG8_SA(0, 1), cA + hstep, voffA);
        if (wr == 1) PG8_BAR;
        PG8_WAIT_V(2); PG8_BAR;
        PG8_STAGE(PG8_SB(1, 0), cB + kstep, voffB); PG8_STAGE(PG8_SA(1, 0), cA + kstep, voffA); PG8_STAGE(PG8_SB(1, 1), cB + hstep + kstep, voffB);
        PG8_WAIT_V(6); PG8_BAR;
    } else {
        PG8_STAGE(PG8_SB(0, 0), cB, voffB); PG8_STAGE(PG8_SA(0, 0), cA, voffA); PG8_STAGE(PG8_SB(0, 1), cB + hstep, voffB); PG8_STAGE(PG8_SA(0, 1), cA + hstep, voffA);
        if (wr == 1) PG8_BAR;
        PG8_WAIT_V(4); PG8_BAR;
        PG8_STAGE(PG8_SB(1, 0), cB + kstep, voffB); PG8_STAGE(PG8_SA(1, 0), cA + kstep, voffA); PG8_STAGE(PG8_SB(1, 1), cB + hstep + kstep, voffB);
        PG8_WAIT_V(6); PG8_BAR;
    }
    for (;;) {
        const bool has_next = S.next(ui + 1, nxt);
        const char* nA = has_next ? (const char*)g.A + (size_t)nxt.pm * tstep : cA; const char* nB = has_next ? (const char*)g.Bt + (size_t)nxt.pn * tstep : cB;
        int ntn_ = nt;
        if constexpr (KCH_T > 0) { if (has_next && nxt.kc) { const size_t ko = (size_t)(nxt.kc - 1) * KCH_T * kstep; nA += ko; nB += ko; ntn_ = KCH_T; } }
        for (int t = 0; t < ntu; t += 2) {
            const bool last = (t == ntu - 2);
            const char* a1 = cA + (size_t)(t + 1) * kstep;
            const char* a2 = last ? nA : cA + (size_t)(t + 2) * kstep; const char* b2 = last ? nB : cB + (size_t)(t + 2) * kstep;
            const char* a3 = a2 + kstep; const char* b3 = b2 + kstep;
            if (last && has_next) S.a_ready(nxt);
            if constexpr (SP2) {
            PG8_LDB(B0, 0, 0); PG8_LDB(B1, 0, 1); PG8_SCHED; PG8_LDA(At, 0, 0); PG8_STAGE(PG8_SA(1, 1), a1 + hstep, voffA);
            PG8_WAIT_V(8); PG8_WAIT_L(0); PG8_BAR; PG8_MMA(0, 0, At, B0); PG8_MMA(0, 1, At, B1); PG8_BAR; PG8_SCHED;
            PG8_LDA(At, 0, 1); PG8_STAGE(PG8_SB(0, 0), b2, voffB); PG8_STAGE(PG8_SB(0, 1), b2 + hstep, voffB); PG8_STAGE(PG8_SA(0, 0), a2, voffA);
            PG8_WAIT_V(8); PG8_WAIT_L(0); PG8_BAR; PG8_MMA(1, 0, At, B0); PG8_MMA(1, 1, At, B1); PG8_BAR; PG8_SCHED;
            PG8_LDB(B0, 1, 0); PG8_LDB(B1, 1, 1); PG8_SCHED; PG8_LDA(At, 1, 0); PG8_STAGE(PG8_SA(0, 1), a2 + hstep, voffA);
            PG8_WAIT_V(8); PG8_WAIT_L(0); PG8_BAR; PG8_MMA(0, 0, At, B0); PG8_MMA(0, 1, At, B1); PG8_BAR; PG8_SCHED;
            PG8_LDA(At, 1, 1); PG8_STAGE(PG8_SB(1, 0), b3, voffB); PG8_STAGE(PG8_SB(1, 1), b3 + hstep, voffB); PG8_STAGE(PG8_SA(1, 0), a3, voffA);
            PG8_WAIT_V(8); PG8_WAIT_L(0); PG8_BAR; PG8_MMA(1, 0, At, B0); PG8_MMA(1, 1, At, B1); PG8_BAR; PG8_SCHED;
            } else {
            PG8_LDB(B0, 0, 0); PG8_SCHED; PG8_LDA(At, 0, 0); PG8_STAGE(PG8_SA(1, 1), a1 + hstep, voffA);
            PG8_WAIT_L(8); PG8_BAR; PG8_WAIT_L(0); PG8_MMA(0, 0, At, B0); PG8_BAR; PG8_SCHED;
            PG8_LDB(B1, 0, 1); PG8_STAGE(PG8_SB(0, 0), b2, voffB);
            PG8_BAR; PG8_WAIT_L(0); PG8_MMA(0, 1, At, B1); PG8_BAR;
            PG8_LDA(At, 0, 1); PG8_STAGE(PG8_SA(0, 0), a2, voffA);
            PG8_BAR; PG8_WAIT_L(0); PG8_MMA(1, 0, At, B0); PG8_BAR; PG8_SCHED;
            PG8_STAGE(PG8_SB(0, 1), b2 + hstep, voffB);
            PG8_WAIT_V(6); PG8_BAR; PG8_MMA(1, 1, At, B1); PG8_BAR;
            PG8_LDB(B0, 1, 0); PG8_SCHED; PG8_LDA(At, 1, 0); PG8_STAGE(PG8_SA(0, 1), a2 + hstep, voffA);
            PG8_WAIT_L(8); PG8_BAR; PG8_WAIT_L(0); PG8_MMA(0, 0, At, B0); PG8_BAR; PG8_SCHED;
            PG8_LDB(B1, 1, 1); PG8_STAGE(PG8_SB(1, 0), b3, voffB);
            PG8_BAR; PG8_WAIT_L(0); PG8_MMA(0, 1, At, B1); PG8_BAR;
            PG8_LDA(At, 1, 1); PG8_STAGE(PG8_SA(1, 0), a3, voffA);
            PG8_BAR; PG8_WAIT_L(0); PG8_MMA(1, 0, At, B0); PG8_BAR; PG8_SCHED;
            PG8_STAGE(PG8_SB(1, 1), b3 + hstep, voffB);
            PG8_WAIT_V(6); PG8_BAR; PG8_MMA(1, 1, At, B1); PG8_BAR;
            }
        }
        if constexpr (ALIGN_EPI) { if (wr == 0) PG8_BAR; }
        if constexpr (FP8) asm volatile("s_nop 15\n\ts_nop 7" ::: "memory");
        if constexpr (!Epi::AFTER_DRAIN) { E(acc, cur, wr, wc, fr, fq); S.done(cur); }
        if (!has_next) break;
#pragma unroll
        for (int a = 0; a < 2; ++a)
#pragma unroll
            for (int b = 0; b < 2; ++b)
#pragma unroll
                for (int m = 0; m < 4; ++m)
#pragma unroll
                    for (int n = 0; n < 2; ++n) { acc[a][b][m][n] = (f32x4){0.f, 0.f, 0.f, 0.f}; }
        cur = nxt; cA = nA; cB = nB; ntu = ntn_; ++ui;
        if constexpr (ALIGN_EPI) { if (wr == 1) PG8_BAR; }
    }
    PG8_WAIT_V(0);
    if constexpr (!ALIGN_EPI) { if (wr == 0) PG8_BAR; }
    PG8_BAR;
#undef PG8_SA
#undef PG8_SB
#undef PG8_STAGE
#undef PG8_LDA
#undef PG8_LDB
#undef PG8_MMA
#undef PG8_CAT
#undef PG8_WAIT_V
#undef PG8_WAIT_L
#undef PG8_BAR
#undef PG8_SCHED
}
}

typedef unsigned short bf16;
typedef unsigned v4u __attribute__((ext_vector_type(4)));
typedef unsigned v2u __attribute__((ext_vector_type(2)));
typedef float f32x4 __attribute__((ext_vector_type(4)));
typedef float f32x16 __attribute__((ext_vector_type(16)));
typedef short bf16x8 __attribute__((ext_vector_type(8)));
typedef short s16x4 __attribute__((ext_vector_type(4)));
#define GAS __attribute__((address_space(1)))
#define LAS __attribute__((address_space(3)))
typedef GAS unsigned gu32;

constexpr int NWAVES = 8, NTHREADS = 512;
constexpr int NB = 2, SEQ = 16384, D = 1024, M = NB * SEQ;
constexpr int DFF = 2816, NE = 8, DFE = 3584;
constexpr float ALPHA = 1.4142135623730951f, LN_EPS = 1e-5f;
constexpr float LOG2E = 1.4426950408889634f;
constexpr float QSCALE = 0.125f * LOG2E;
constexpr int NPHASE = 22;
constexpr float SX8 = 16.f, SWQ8 = 256.f, SW13_8 = 256.f, SW2_8 = 2048.f, SH8 = 8.f, SY8 = 8.f, SWG8 = 256.f, SWI8 = 256.f, SO8 = 64.f, SWO8 = 512.f;

constexpr size_t MiB = 1u << 20;
constexpr size_t WS_CTL = 0, CTL_ZERO_BYTES = 1 * MiB;
constexpr size_t WS_TAB = 1 * MiB;
constexpr size_t TAB_BB = 0, TAB_CC = 256 * 1024, TAB_AB = 576 * 1024, TAB_BIAS = 704 * 1024, TAB_CV13 = 768 * 1024, TAB_CVQKV = 832 * 1024;
constexpr size_t WS_ROUTE = 2 * MiB;
constexpr size_t ROUTE_I = 0, ROUTE_G = 512 * 1024, ROUTE_ST = 768 * 1024;
constexpr int MAXTILES = 264, MAXSLOT = MAXTILES * 256, RTILES = 132;
constexpr size_t WS_E = 4 * MiB;
constexpr size_t WS_LSE = 5 * MiB;
constexpr size_t WS_W = 10 * MiB;
constexpr size_t W_IN = WS_W, W_GLU = WS_W + 2 * MiB, W_13 = WS_W + 6 * MiB, W_2 = WS_W + 17 * MiB, W_QKV = WS_W + 23 * MiB, W_O = 533 * MiB;
constexpr size_t WM_13 = WS_W, WM_2 = 505 * MiB;
constexpr size_t WS_XB0 = 56 * MiB, WS_U = 120 * MiB, WS_YB = 184 * MiB, WS_Z = 248 * MiB, WS_X1B = 376 * MiB, WS_HF = 56 * MiB, WS_X2B = 440 * MiB;
constexpr size_t WS_Q = 56 * MiB, WS_K = 120 * MiB, WS_V = 184 * MiB, WS_O0 = 248 * MiB, WS_O1 = 312 * MiB, WS_Z2 = 184 * MiB, WS_X3B = 94 * MiB, WS_X2Q = 376 * MiB, WS_X3Q = 408 * MiB, WS_MQ = 376 * MiB;
constexpr size_t WS_XG = 190 * MiB, WS_H = 256 * MiB, WS_Z2B = 440 * MiB, WS_ST = 504 * MiB, ST_BYTES = 2 * (size_t)M * 8, WS_END = 534 * MiB;
static_assert(WS_H + (size_t)MAXTILES * 256 * DFE <= WS_ST && WS_XG + (size_t)MAXTILES * 256 * D <= WS_H && WM_13 + (size_t)NE * 2 * DFE * D <= WS_X3B && WM_2 + (size_t)NE * D * DFE <= W_O && W_O + (size_t)D * D <= WS_END && WS_ST + ST_BYTES <= WM_2, "moe buffers");
constexpr int CW_CNT = 64;
constexpr int CW_BAR = 4096;

constexpr int RING_BYTES = 139264;
constexpr int LDSCTL_OFF = RING_BYTES;
constexpr int LDS_BYTES = 147456;

#define RLX_AGENT __ATOMIC_RELAXED, __HIP_MEMORY_SCOPE_AGENT
#define VM_WAIT() asm volatile("s_waitcnt vmcnt(0)" ::: "memory")
#define LDS_WAIT() asm volatile("s_waitcnt lgkmcnt(0)" ::: "memory")
using pg8::cvt_pk_bf16; using pg8::bf_lo; using pg8::bf_hi; using pg8::pk4_fp8;

#define XB_TMO      128
#define XB_XCNT(j)  (256  + 64 * (j))
#define XB_XSUB(j)  (1280 + 64 * (j))
#define XB_XGEN(j)  (2304 + 64 * (j))
#define XB_TOP      3328
#define XB_TOPGEN   3392
#define XCD_BAR_WORDS 3456
#define XB_SPIN_CAP (1u << 18)
__device__ __forceinline__ unsigned xb_ld(unsigned* p)              { return __hip_atomic_load(p, __ATOMIC_RELAXED, __HIP_MEMORY_SCOPE_AGENT); }
__device__ __forceinline__ unsigned xb_add(unsigned* p, unsigned v) { return __hip_atomic_fetch_add(p, v, __ATOMIC_RELAXED, __HIP_MEMORY_SCOPE_AGENT); }
__device__ __forceinline__ unsigned xb_xcc_id() { return (unsigned)__builtin_amdgcn_s_getreg((3 << 11) | 20) & 0xFu; }
#define XB_SPIN(cond, bar) do { unsigned _sp = 0; while (cond) { __builtin_amdgcn_s_sleep(1); \
    if ((++_sp & 255u) == 0u) { if (xb_ld(&(bar)[XB_TMO])) break; if (_sp > XB_SPIN_CAP) { atomicAdd(&(bar)[XB_TMO], 1u); break; } } } } while (0)
struct XcdBarrier { unsigned* bar; unsigned x; volatile LAS unsigned* st; };
__device__ __forceinline__ XcdBarrier xcd_barrier_post(unsigned* bar, volatile LAS unsigned* st) {
    XcdBarrier b; b.bar = bar; b.x = xb_xcc_id(); b.st = st;
    if (threadIdx.x == 0) (void)xb_add(&bar[XB_XCNT(b.x)], 1u);
    return b;
}
__device__ __forceinline__ void xcd_barrier_complete(unsigned* bar, unsigned x, unsigned& nloc, unsigned& nx) {
    const unsigned G = gridDim.x * gridDim.y * gridDim.z;
    unsigned sum, cnt, mine, sp = 0u;
    for (;;) {
        sum = 0u; cnt = 0u; mine = 0u;
#pragma unroll
        for (unsigned j = 0; j < 16; ++j) { const unsigned c = xb_ld(&bar[XB_XCNT(j)]); sum += c; cnt += (c > 0u) ? 1u : 0u; mine = (j == x) ? c : mine; }
        if (sum == G) break;
        __builtin_amdgcn_s_sleep(1);
        if ((++sp & 255u) == 0u) { if (xb_ld(&bar[XB_TMO])) break; if (sp > XB_SPIN_CAP) { atomicAdd(&bar[XB_TMO], 1u); break; } }
    }
    nloc = mine > 0u ? mine : 1u; nx = cnt > 0u ? cnt : 1u;
}
__device__ __forceinline__ void xcd_barrier(const XcdBarrier& b) {
    asm volatile("s_waitcnt vmcnt(0)" ::: "memory");
    __syncthreads();
    if (threadIdx.x == 0) {
        unsigned* bar = b.bar;
        __builtin_amdgcn_s_waitcnt(0);
        unsigned nloc = b.st[0], nx = b.st[1];
        if (nloc == 0u) { xcd_barrier_complete(bar, b.x, nloc, nx); b.st[0] = nloc; b.st[1] = nx; }
        const unsigned old = xb_add(&bar[XB_XSUB(b.x)], 1u);
        const unsigned gen = old / nloc;
        if (old + 1u == (gen + 1u) * nloc) {
            __builtin_amdgcn_fence(__ATOMIC_RELEASE, "agent");
            asm volatile("s_waitcnt vmcnt(0)" ::: "memory");
            const unsigned og = xb_add(&bar[XB_TOP], 1u);
            const unsigned tg = og / nx;
            if (og + 1u == (tg + 1u) * nx) xb_add(&bar[XB_TOPGEN], 1u);
            else XB_SPIN((int)(xb_ld(&bar[XB_TOPGEN]) - (tg + 1u)) < 0, bar);
            __builtin_amdgcn_fence(__ATOMIC_ACQUIRE, "agent");
            xb_add(&bar[XB_XGEN(b.x)], 1u);
            asm volatile("s_waitcnt vmcnt(0)" ::: "memory");
        } else {
            XB_SPIN((int)(xb_ld(&bar[XB_XGEN(b.x)]) - (gen + 1u)) < 0, bar);
            __builtin_amdgcn_fence(__ATOMIC_ACQUIRE, "agent");
            asm volatile("s_waitcnt vmcnt(0)" ::: "memory");
        }
    }
    __syncthreads();
}

__device__ __forceinline__ void xcd_barrier_arrive(const XcdBarrier& b) {
    asm volatile("s_waitcnt vmcnt(0)" ::: "memory");
    __syncthreads();
    if (threadIdx.x == 0) {
        unsigned* bar = b.bar;
        __builtin_amdgcn_s_waitcnt(0);
        unsigned nloc = b.st[0], nx = b.st[1];
        if (nloc == 0u) { xcd_barrier_complete(bar, b.x, nloc, nx); b.st[0] = nloc; b.st[1] = nx; }
        const unsigned old = xb_add(&bar[XB_XSUB(b.x)], 1u);
        const unsigned gen = old / nloc; const bool leader = old + 1u == (gen + 1u) * nloc;
        if (leader) {
            __builtin_amdgcn_fence(__ATOMIC_RELEASE, "agent");
            asm volatile("s_waitcnt vmcnt(0)" ::: "memory");
            const unsigned og = xb_add(&bar[XB_TOP], 1u);
            const unsigned tg = og / nx;
            if (og + 1u == (tg + 1u) * nx) xb_add(&bar[XB_TOPGEN], 1u);
        }
        b.st[2] = gen; b.st[3] = leader ? 1u : 0u;
    }
}
__device__ __forceinline__ void xcd_barrier_wait(const XcdBarrier& b) {
    asm volatile("s_waitcnt vmcnt(0)" ::: "memory");
    __syncthreads();
    if (threadIdx.x == 0) {
        unsigned* bar = b.bar;
        const unsigned gen = b.st[2], leader = b.st[3];
        XB_SPIN((int)(xb_ld(&bar[XB_TOPGEN]) - (gen + 1u)) < 0, bar);
        __builtin_amdgcn_fence(__ATOMIC_ACQUIRE, "agent");
        if (leader) xb_add(&bar[XB_XGEN(b.x)], 1u);
        asm volatile("s_waitcnt vmcnt(0)" ::: "memory");
    }
    __syncthreads();
}

struct Frame {
    LAS unsigned char* lds;
    unsigned char* ws;
    int tid, lane, wave, vcu, G;
};

__device__ __forceinline__ float wave_sum(float v) {
#pragma unroll
    for (int o = 1; o < 64; o <<= 1) v += __shfl_xor(v, o);
    return v;
}

constexpr int TR_SCR_BYTES = 17408;
__device__ __forceinline__ void tr_load(f32x4 (&v)[16], const float* W, int ld, int k0, int n0, int lane) {
    const int l16 = lane & 15, kq = lane >> 4;
#pragma unroll
    for (int i = 0; i < 16; ++i) v[i] = *(const GAS f32x4*)(W + (size_t)(k0 + 4 * i + kq) * ld + n0 + 4 * l16);
}
template <bool FP8> __device__ __forceinline__ void tr_finish(f32x4 (&v)[16], int K, void* WTv, int k0, int drow0, float sc, const float* gk, LAS float* scr, int lane) {
    const int l16 = lane & 15, kq = lane >> 4;
    if (gk) {
#pragma unroll
        for (int i = 0; i < 16; ++i) v[i] = v[i] * gk[k0 + 4 * i + kq]; }
#pragma unroll
    for (int i = 0; i < 16; ++i) { const int k = 4 * i + kq; LAS float* d = scr + k * 65 + (k >> 3) * 4 + 4 * l16; d[0] = v[i][0]; d[1] = v[i][1]; d[2] = v[i][2]; d[3] = v[i][3]; }
    LDS_WAIT(); asm volatile("" ::: "memory");
#define TR_AT(k, n) scr[(k) * 65 + ((k) >> 3) * 4 + (n)]
    if constexpr (FP8) { unsigned char* WT = (unsigned char*)WTv; const int c = lane & 3;
#pragma unroll
        for (int j = 0; j < 4; ++j) { const int n = (lane >> 2) + 16 * j; v4u o;
#pragma unroll
            for (int q = 0; q < 4; ++q) { const int k = 16 * c + 4 * q; o[q] = pk4_fp8(TR_AT(k, n) * sc, TR_AT(k + 1, n) * sc, TR_AT(k + 2, n) * sc, TR_AT(k + 3, n) * sc); }
            *(GAS v4u*)(WT + (size_t)(drow0 + n) * K + k0 + 16 * c) = o; }
    } else { bf16* WT = (bf16*)WTv; const int c = lane & 7;
#pragma unroll
        for (int j = 0; j < 8; ++j) { const int n = (lane >> 3) + 8 * j; v4u o;
#pragma unroll
            for (int q = 0; q < 4; ++q) { const int k = 8 * c + 2 * q; o[q] = cvt_pk_bf16(TR_AT(k, n) * sc, TR_AT(k + 1, n) * sc); }
            *(GAS v4u*)(WT + (size_t)(drow0 + n) * K + k0 + 8 * c) = o; }
    }
#undef TR_AT
    LDS_WAIT(); asm volatile("" ::: "memory");
}
template <bool FP8 = false> __device__ __forceinline__ void transpose_matrix(const float* W, int K, int N, int ld, void* WT, int split, int half, float scale, const float* gk, LAS float* scr, int lane, int gw, int NGW, int& cursor) {
    const int nblk = N / 64, nitems = (K / 64) * nblk;
    int it = (gw - cursor % NGW + NGW) % NGW;
    cursor += nitems;
    if (it >= nitems) return;
    f32x4 v[16], vn[16];
    tr_load(v, W, ld, 64 * (it / nblk), 64 * (it % nblk), lane);
    for (;;) { const int itn = it + NGW; const bool hn = itn < nitems;
        if (hn) tr_load(vn, W, ld, 64 * (itn / nblk), 64 * (itn % nblk), lane);
        const int kb = it / nblk, n0 = 64 * (it % nblk);
        const int drow0 = split == 1 ? ((n0 >> 7) * 256 + half * 128 + (n0 & 127)) : n0;
        const float sc = (split == 2 && (n0 % 3072) < 1024) ? QSCALE * scale : scale;
        tr_finish<FP8>(v, K, WT, 64 * kb, drow0, sc, gk, scr, lane);
        if (!hn) break;
#pragma unroll
        for (int i = 0; i < 16; ++i) v[i] = vn[i];
        it = itn; }
}

__device__ __forceinline__ int t5_bucket(int d) {
    if (d < 16) return d;
    int b = 16;
    b += (d >= 22) + (d >= 30) + (d >= 40) + (d >= 54) + (d >= 73) + (d >= 99) + (d >= 134) + (d >= 182) + (d >= 246) + (d >= 332) + (d >= 450) + (d >= 609) + (d >= 825) + (d >= 1117) + (d >= 1513);
    return b;
}

struct In { const float* p[23]; };
typedef const __attribute__((address_space(4))) unsigned char* kaptr_t;
__device__ __forceinline__ kaptr_t ka_fresh() { kaptr_t p = (kaptr_t)__builtin_amdgcn_kernarg_segment_ptr(); asm volatile("" : "+s"(p)); return p; }
#define INP(k) (*(const float* const __attribute__((address_space(4)))*)(ka_fresh() + 8 * (k)))

template <int PART> __device__ __forceinline__ void p0_prologue(Frame& F) {
    LAS float* scr = (LAS float*)(F.lds + F.wave * TR_SCR_BYTES);
    const int gw = F.vcu * NWAVES + F.wave, NGW = F.G * NWAVES;
    int cur = 0;
    if constexpr (PART == 0) {
    transpose_matrix<true>(INP(1), D, D, D, (void*)(F.ws + W_IN), 0, 0, SWI8, nullptr, scr, F.lane, gw, NGW, cur);
    } else {
    transpose_matrix<true>(INP(10), D, D, 2 * D, (void*)(F.ws + W_GLU), 1, 0, SWG8, nullptr, scr, F.lane, gw, NGW, cur);
    transpose_matrix<true>(INP(10) + D, D, D, 2 * D, (void*)(F.ws + W_GLU), 1, 1, SWG8, nullptr, scr, F.lane, gw, NGW, cur);
    }
    if constexpr (PART == 0) {
    { const float* x = INP(0); unsigned char* xq = (unsigned char*)(F.ws + WS_XB0); const size_t n16 = (size_t)M * D / 16; const size_t gt = (size_t)gw * 64 + F.lane, NT = (size_t)NGW * 64;
      for (size_t i0 = gt; i0 < n16; i0 += 4 * NT) {
          f32x4 v[4][4];
#pragma unroll
          for (int t = 0; t < 4; ++t) { const size_t i = i0 + t * NT; if (i < n16) {
#pragma unroll
              for (int q = 0; q < 4; ++q) v[t][q] = *(const GAS f32x4*)(x + i * 16 + 4 * q); } }
#pragma unroll
          for (int t = 0; t < 4; ++t) { const size_t i = i0 + t * NT; if (i < n16) { v4u o;
#pragma unroll
              for (int q = 0; q < 4; ++q) { const f32x4 a = v[t][q] * SX8; o[q] = pk4_fp8(a[0], a[1], a[2], a[3]); }
              *(GAS v4u*)(xq + i * 16) = o; } } } }
    return; }
    const int gt = gw * 64 + F.lane, NT = NGW * 64;
    const float* a_re = INP(2); const float* a_im = INP(3); const float* log_dt = INP(4); const float* b_re = INP(5); const float* b_im = INP(6);
    const float* c_re = INP(7); const float* c_im = INP(8); const float* dsk = INP(9);
    for (int i = gt; i < 64 * 4 * 64; i += NT) { const int l = i & 63, j = (i >> 6) & 3, g = i >> 8; const int p = (l & 31) + 32 * (j >> 1);
        const double dt = exp((double)log_dt[g]); const double lr = fmin((double)a_re[g * 64 + p], -1e-4), li = (double)a_im[g * 64 + p];
        const double mag = exp(lr * dt), abr = mag * cos(li * dt), abi = mag * sin(li * dt), den = lr * lr + li * li, nr = abr - 1.0;
        const double qr = (nr * lr + abi * li) / den, qi = (abi * lr - nr * li) / den;
        float v[8];
#pragma unroll
        for (int e = 0; e < 8; ++e) { const int c = 8 * (l >> 5) + e; const double br = b_re[(g * 64 + p) * 16 + c], bi = b_im[(g * 64 + p) * 16 + c];
            v[e] = (float)((j & 1) ? (qr * bi + qi * br) : (qr * br - qi * bi)); }
        v4u o; o.x = cvt_pk_bf16(v[0], v[1]); o.y = cvt_pk_bf16(v[2], v[3]); o.z = cvt_pk_bf16(v[4], v[5]); o.w = cvt_pk_bf16(v[6], v[7]);
        *(GAS v4u*)(F.ws + WS_TAB + TAB_BB + (size_t)i * 16) = o; }
    for (int i = gt; i < 64 * 5 * 64; i += NT) { const int l = i & 63, ks = (i >> 6) % 5, g = i / 320; const int c = l & 15;
        float v[8];
#pragma unroll
        for (int e = 0; e < 8; ++e) { const int kk = 8 * (l >> 4) + e;
            if (ks < 4) { const int k2 = 32 * ks + kk, n = k2 >> 2, q = k2 & 3, p = n + 32 * (q >> 1); v[e] = (q & 1) ? -c_im[(g * 16 + c) * 64 + p] : c_re[(g * 16 + c) * 64 + p]; }
            else v[e] = (kk == c) ? dsk[g * 16 + c] : 0.f; }
        v4u o; o.x = cvt_pk_bf16(v[0], v[1]); o.y = cvt_pk_bf16(v[2], v[3]); o.z = cvt_pk_bf16(v[4], v[5]); o.w = cvt_pk_bf16(v[6], v[7]);
        *(GAS v4u*)(F.ws + WS_TAB + TAB_CC + (size_t)i * 16) = o; }
    for (int i = gt; i < 64 * 32 * 4; i += NT) { const int pw = i & 3, n = (i >> 2) & 31, g = i >> 7; const double kpow = pw == 0 ? 1.0 : pw == 1 ? 16.0 : pw == 2 ? 32.0 : 1024.0;
        const double dt = exp((double)log_dt[g]); f32x4 o;
#pragma unroll
        for (int s = 0; s < 2; ++s) { const int p = n + 32 * s; const double lr = fmin((double)a_re[g * 64 + p], -1e-4), li = (double)a_im[g * 64 + p];
            const double mag = exp(kpow * lr * dt); o[2 * s] = (float)(mag * cos(kpow * li * dt)); o[2 * s + 1] = (float)(mag * sin(kpow * li * dt)); }
        *(GAS f32x4*)(F.ws + WS_TAB + TAB_AB + (size_t)i * 16) = o; }
    { const float* relb = INP(13);
      for (int i = gt; i < 3 * 16 * 256; i += NT) { const int y = i & 255, h = (i >> 8) & 15, g = i >> 12; const int dil = g == 0 ? 1 : g == 1 ? 4 : 16; const int off = 191 - y;
          const float v = (off >= 0 && off <= 128) ? relb[t5_bucket(off * dil) * 16 + h] * LOG2E : -1e30f;
          *(GAS float*)(F.ws + WS_TAB + TAB_BIAS + (size_t)i * 4) = v; } }
}

template <bool FP8> __device__ __forceinline__ void colvec_pass(Frame& F, const void* Wt, int nrows, float inv_scale, const float* gam, const float* bet, float* cv, float* dv) {
    const int gw = F.vcu * NWAVES + F.wave, NGW = F.G * NWAVES;
    float ratio[16];
#pragma unroll
    for (int j = 0; j < 16; ++j) ratio[j] = bet[F.lane * 16 + j] / gam[F.lane * 16 + j];
    for (int n = gw; n < nrows; n += NGW) { float w[16];
        if constexpr (FP8) { const v4u q = *(const GAS v4u*)((const unsigned char*)Wt + (size_t)n * D + F.lane * 16);
#pragma unroll
            for (int j = 0; j < 4; ++j) { w[4 * j] = __builtin_amdgcn_cvt_f32_fp8((int)q[j], 0); w[4 * j + 1] = __builtin_amdgcn_cvt_f32_fp8((int)q[j], 1); w[4 * j + 2] = __builtin_amdgcn_cvt_f32_fp8((int)q[j], 2); w[4 * j + 3] = __builtin_amdgcn_cvt_f32_fp8((int)q[j], 3); }
        } else { const v4u q0 = *(const GAS v4u*)((const bf16*)Wt + (size_t)n * D + F.lane * 16), q1 = *(const GAS v4u*)((const bf16*)Wt + (size_t)n * D + F.lane * 16 + 8);
#pragma unroll
            for (int j = 0; j < 4; ++j) { w[2 * j] = bf_lo(q0[j]); w[2 * j + 1] = bf_hi(q0[j]); w[8 + 2 * j] = bf_lo(q1[j]); w[8 + 2 * j + 1] = bf_hi(q1[j]); } }
        float c = 0.f, d = 0.f;
#pragma unroll
        for (int j = 0; j < 16; ++j) { c += w[j]; d += w[j] * ratio[j]; }
        c = wave_sum(c) * inv_scale; d = wave_sum(d) * inv_scale;
        if (F.lane == 0) { cv[n] = c; dv[n] = d; } }
}

__device__ __forceinline__ float gelu_tanh(float x) { const float z = 1.5957691216057308f * (x + 0.044715f * x * x * x); return x * pg8::sigmoidf_fast(z); }
#define CMUL_ADD(or_, oi_, ar_, ai_, hr_, hi_, br_, bi_) do { float _p = fmaf((ar_), (hr_), (br_)); asm("" : "+v"(_p)); float _q = fmaf((ar_), (hi_), (bi_)); const float _t = fmaf(-(ai_), (hi_), _p); asm("" : "+v"(_q)); const float _u = fmaf((ai_), (hr_), _q); or_ = _t; oi_ = _u; } while (0)

template <bool OUT> __device__ __forceinline__ void s5_phase(Frame& F) {
    const int lane = F.lane, n = lane & 31, hh = lane >> 5;
    LAS unsigned char* ldsw = F.lds + F.wave * 8704;
    const int gw = F.vcu * NWAVES + F.wave, NGW = F.G * NWAVES;
    const bf16* U = (const bf16*)(F.ws + WS_U); bf16* Yb = (bf16*)(F.ws + WS_YB); float* E = (float*)(F.ws + WS_E);
    const int tokA = ((n >> 2) & 1) * 16 + (n >> 3) * 4 + (n & 3);
    for (int unit = gw; unit < 2048; unit += NGW) {
        const int bg = unit >> 4, c = unit & 15, b = bg >> 6, g = bg & 63;
        const bf16* up = U + ((size_t)bg * 16384 + (size_t)c * 1024) * 16;
        bf16x8 BBf[4];
#pragma unroll
        for (int j = 0; j < 4; ++j) BBf[j] = *(const GAS bf16x8*)(F.ws + WS_TAB + TAB_BB + ((size_t)(g * 4 + j) * 64 + lane) * 16);
        const f32x4 a1 = *(const GAS f32x4*)(F.ws + WS_TAB + TAB_AB + ((size_t)(g * 32 + n) * 4 + 0) * 16);
        const f32x4 a16 = *(const GAS f32x4*)(F.ws + WS_TAB + TAB_AB + ((size_t)(g * 32 + n) * 4 + 1) * 16);
        const f32x4 a32 = *(const GAS f32x4*)(F.ws + WS_TAB + TAB_AB + ((size_t)(g * 32 + n) * 4 + 2) * 16);
        bf16x8 CCf[5];
        float s0r = 0.f, s0i = 0.f, s1r = 0.f, s1i = 0.f;
        if constexpr (OUT) {
#pragma unroll
            for (int ks = 0; ks < 5; ++ks) CCf[ks] = *(const GAS bf16x8*)(F.ws + WS_TAB + TAB_CC + ((size_t)(g * 5 + ks) * 64 + lane) * 16);
            const f32x4 ak = *(const GAS f32x4*)(F.ws + WS_TAB + TAB_AB + ((size_t)(g * 32 + n) * 4 + 3) * 16);
            f32x4 ev[15];
#pragma unroll
            for (int cp = 0; cp < 15; ++cp) { ev[cp] = (f32x4){0.f, 0.f, 0.f, 0.f}; if (cp < c) ev[cp] = *(const GAS f32x4*)(E + ((size_t)(bg * 16 + cp) * 128 + 4 * n)); }
#pragma unroll
            for (int cp = 0; cp < 15; ++cp) if (cp < c) { CMUL_ADD(s0r, s0i, ak[0], ak[1], s0r, s0i, ev[cp][0], ev[cp][1]); CMUL_ADD(s1r, s1i, ak[2], ak[3], s1r, s1i, ev[cp][2], ev[cp][3]); }
        }
        bf16x8 Af = *(const GAS bf16x8*)(up + (size_t)tokA * 16 + 8 * hh);
        const int tq_ = lane >> 4, tl_ = lane & 15;
        bf16x8 Bun[2] = {{0, 0, 0, 0, 0, 0, 0, 0}, {0, 0, 0, 0, 0, 0, 0, 0}};
        if constexpr (OUT) { if (tq_ < 2) { Bun[0] = *(const GAS bf16x8*)(up + (size_t)tl_ * 16 + 8 * tq_); Bun[1] = *(const GAS bf16x8*)(up + (size_t)(16 + tl_) * 16 + 8 * tq_); } }
#pragma unroll 2
        for (int tile = 0; tile < 32; ++tile) {
            const bf16x8 Ac = Af; const bf16x8 Bu0 = Bun[0], Bu1 = Bun[1];
            if (tile + 1 < 32) { Af = *(const GAS bf16x8*)(up + (size_t)((tile + 1) * 32 + tokA) * 16 + 8 * hh);
                if constexpr (OUT) { if (tq_ < 2) { Bun[0] = *(const GAS bf16x8*)(up + (size_t)((tile + 1) * 32 + tl_) * 16 + 8 * tq_); Bun[1] = *(const GAS bf16x8*)(up + (size_t)((tile + 1) * 32 + 16 + tl_) * 16 + 8 * tq_); } } }
            f32x16 bu[4];
#pragma unroll
            for (int j = 0; j < 4; ++j) { f32x16 z = {}; asm volatile("" : "+v"(z)); bu[j] = __builtin_amdgcn_mfma_f32_32x32x16_bf16(Ac, BBf[j], z, 0, 0, 0); }
            float e0r = 0.f, e0i = 0.f, e1r = 0.f, e1i = 0.f;
#pragma unroll
            for (int r = 0; r < 16; ++r) { CMUL_ADD(e0r, e0i, a1[0], a1[1], e0r, e0i, bu[0][r], bu[1][r]); CMUL_ADD(e1r, e1i, a1[2], a1[3], e1r, e1i, bu[2][r], bu[3][r]); }
            float lo0r, lo0i, lo1r, lo1i, hi0r, hi0i, hi1r, hi1i;
            { const float o = __shfl_xor(e0r, 32); lo0r = hh ? o : e0r; hi0r = hh ? e0r : o; }
            { const float o = __shfl_xor(e0i, 32); lo0i = hh ? o : e0i; hi0i = hh ? e0i : o; }
            { const float o = __shfl_xor(e1r, 32); lo1r = hh ? o : e1r; hi1r = hh ? e1r : o; }
            { const float o = __shfl_xor(e1i, 32); lo1i = hh ? o : e1i; hi1i = hh ? e1i : o; }
            float m0r, m0i, m1r, m1i;
            CMUL_ADD(m0r, m0i, a16[0], a16[1], s0r, s0i, lo0r, lo0i); CMUL_ADD(m1r, m1i, a16[2], a16[3], s1r, s1i, lo1r, lo1i);
            if constexpr (OUT) {
                float h0r = hh ? m0r : s0r, h0i = hh ? m0i : s0i, h1r = hh ? m1r : s1r, h1i = hh ? m1i : s1i;
#pragma unroll
                for (int r = 0; r < 16; ++r) { CMUL_ADD(h0r, h0i, a1[0], a1[1], h0r, h0i, bu[0][r], bu[1][r]); CMUL_ADD(h1r, h1i, a1[2], a1[3], h1r, h1i, bu[2][r], bu[3][r]);
                    v2u w; w.x = cvt_pk_bf16(h0r, h0i); w.y = cvt_pk_bf16(h1r, h1i);
                    *(LAS v2u*)(ldsw + (16 * hh + r) * 272 + 8 * n) = w; }
            }
            asm volatile("" ::: "memory");
            CMUL_ADD(s0r, s0i, a16[0], a16[1], m0r, m0i, hi0r, hi0i); CMUL_ADD(s1r, s1i, a16[2], a16[3], m1r, m1i, hi1r, hi1i);
            if constexpr (OUT) {
                const int tq = lane >> 4, tl = lane & 15;
#pragma unroll
                for (int nt = 0; nt < 2; ++nt) {
                    pg8::f32x4 acc = {0.f, 0.f, 0.f, 0.f}; asm volatile("" : "+v"(acc));
#pragma unroll
                    for (int ks = 0; ks < 4; ++ks) { const bf16x8 Bf = *(const LAS bf16x8*)(ldsw + (16 * nt + tl) * 272 + (32 * ks + 8 * tq) * 2);
                        acc = __builtin_amdgcn_mfma_f32_16x16x32_bf16(CCf[ks], Bf, acc, 0, 0, 0); }
                    acc = __builtin_amdgcn_mfma_f32_16x16x32_bf16(CCf[4], nt == 0 ? Bu0 : Bu1, acc, 0, 0, 0);
                    *(GAS unsigned*)((unsigned char*)Yb + ((size_t)(b * SEQ + c * 1024 + tile * 32 + 16 * nt + tl)) * D + g * 16 + 4 * tq) = pk4_fp8(gelu_tanh(acc[0]) * SY8, gelu_tanh(acc[1]) * SY8, gelu_tanh(acc[2]) * SY8, gelu_tanh(acc[3]) * SY8);
                }
                asm volatile("" ::: "memory");
            }
        }
        if constexpr (!OUT) { if (hh == 0) { f32x4 o = {s0r, s0i, s1r, s1i}; *(GAS f32x4*)(E + ((size_t)(bg * 16 + c) * 128 + 4 * n)) = o; } }
    }
}

__device__ __forceinline__ void ln_stats(const f32x4 (&v)[4], float& mean, float& rstd) {
    float s = 0.f;
#pragma unroll
    for (int j = 0; j < 4; ++j) s += (v[j][0] + v[j][1]) + (v[j][2] + v[j][3]);
    mean = wave_sum(s) * (1.f / D); float s2 = 0.f;
#pragma unroll
    for (int j = 0; j < 4; ++j) { const f32x4 d = v[j] - mean; s2 += (d[0] * d[0] + d[1] * d[1]) + (d[2] * d[2] + d[3] * d[3]); }
    rstd = 1.0f / sqrtf(wave_sum(s2) * (1.f / D) + LN_EPS);
}
template <bool Q8> __device__ __forceinline__ void ln_pass(Frame& F, const bf16* Z, const float* gam, const float* bet, bf16* xb, unsigned char* xq) {
    const int gw = F.vcu * NWAVES + F.wave, NGW = F.G * NWAVES;
    f32x4 gv[4], bv[4];
#pragma unroll
    for (int j = 0; j < 4; ++j) { gv[j] = *(const GAS f32x4*)(gam + F.lane * 4 + 256 * j); bv[j] = *(const GAS f32x4*)(bet + F.lane * 4 + 256 * j); }
    for (int row = gw; row < M; row += NGW) {
        f32x4 v[4];
#pragma unroll
        for (int j = 0; j < 4; ++j) { const v2u zw = *(const GAS v2u*)(Z + (size_t)row * D + F.lane * 4 + 256 * j); v[j] = (f32x4){bf_lo(zw.x), bf_hi(zw.x), bf_lo(zw.y), bf_hi(zw.y)}; }
        float mean, rstd; ln_stats(v, mean, rstd);
#pragma unroll
        for (int j = 0; j < 4; ++j) { const f32x4 y = (v[j] - mean) * rstd * gv[j] + bv[j]; v2u w; w.x = cvt_pk_bf16(y[0], y[1]); w.y = cvt_pk_bf16(y[2], y[3]);
            *(GAS v2u*)(xb + (size_t)row * D + F.lane * 4 + 256 * j) = w;
            if constexpr (Q8) *(GAS unsigned*)(xq + (size_t)row * D + F.lane * 4 + 256 * j) = pk4_fp8(y[0] * SX8, y[1] * SX8, y[2] * SX8, y[3] * SX8); }
    }
}
__device__ __forceinline__ void ln_router_pass(Frame& F, const bf16* Z, const float* gam, const float* bet, const float* wr, bf16* xb, unsigned char* xq) {
    f32x4 gv[4], bv[4];
#pragma unroll
    for (int j = 0; j < 4; ++j) { gv[j] = *(const GAS f32x4*)(gam + F.lane * 4 + 256 * j); bv[j] = *(const GAS f32x4*)(bet + F.lane * 4 + 256 * j); }
    f32x4 w0[4][4], w1[4][4];
#pragma unroll
    for (int j = 0; j < 4; ++j)
#pragma unroll
        for (int i = 0; i < 4; ++i) { const int k = F.lane * 4 + 256 * j + i; w0[j][i] = *(const GAS f32x4*)(wr + (size_t)k * 8); w1[j][i] = *(const GAS f32x4*)(wr + (size_t)k * 8 + 4); }
    volatile LAS unsigned* lcnt = (volatile LAS unsigned*)(F.lds + LDSCTL_OFF + 64);
    volatile LAS unsigned* lbase = (volatile LAS unsigned*)(F.lds + LDSCTL_OFF + 96);
    LAS unsigned* rinfo = (LAS unsigned*)(F.lds);
    if (F.tid < 8) lcnt[F.tid] = 0u;
    __syncthreads();
    int* slot_tok = (int*)(F.ws + WS_ROUTE + ROUTE_ST);
    for (int i = blockIdx.x * NTHREADS + F.tid; i < MAXSLOT; i += F.G * NTHREADS) slot_tok[i] = -1;
    const int rowb = blockIdx.x * 128;
    v2u zn[4];
#pragma unroll
    for (int j = 0; j < 4; ++j) zn[j] = *(const GAS v2u*)(Z + (size_t)(rowb + F.wave * 16) * D + F.lane * 4 + 256 * j);
    for (int k = 0; k < 16; ++k) {
        const int rl = F.wave * 16 + k, row = rowb + rl;
        f32x4 v[4];
#pragma unroll
        for (int j = 0; j < 4; ++j) v[j] = (f32x4){bf_lo(zn[j].x), bf_hi(zn[j].x), bf_lo(zn[j].y), bf_hi(zn[j].y)};
        if (k + 1 < 16) {
#pragma unroll
            for (int j = 0; j < 4; ++j) zn[j] = *(const GAS v2u*)(Z + (size_t)(row + 1) * D + F.lane * 4 + 256 * j); }
        float mean, rstd; ln_stats(v, mean, rstd);
        f32x4 la = {0.f, 0.f, 0.f, 0.f}, lb = {0.f, 0.f, 0.f, 0.f};
#pragma unroll
        for (int j = 0; j < 4; ++j) { const f32x4 y = (v[j] - mean) * rstd * gv[j] + bv[j]; v2u w; w.x = cvt_pk_bf16(y[0], y[1]); w.y = cvt_pk_bf16(y[2], y[3]);
            *(GAS v2u*)(xb + (size_t)row * D + F.lane * 4 + 256 * j) = w;
            *(GAS unsigned*)(xq + (size_t)row * D + F.lane * 4 + 256 * j) = pk4_fp8(y[0] * SX8, y[1] * SX8, y[2] * SX8, y[3] * SX8);
#pragma unroll
            for (int i = 0; i < 4; ++i) { la += w0[j][i] * y[i]; lb += w1[j][i] * y[i]; } }
        float lg[8];
#pragma unroll
        for (int e = 0; e < 4; ++e) { lg[e] = wave_sum(la[e]); lg[4 + e] = wave_sum(lb[e]); }
        int e1 = 0; float v1 = lg[0];
#pragma unroll
        for (int e = 1; e < 8; ++e) if (lg[e] > v1) { v1 = lg[e]; e1 = e; }
        int e2 = -1; float v2 = -INFINITY;
#pragma unroll
        for (int e = 0; e < 8; ++e) if (e != e1 && lg[e] > v2) { v2 = lg[e]; e2 = e; }
        const float t = __expf(v2 - v1), g1 = 1.0f / (1.0f + t), g2 = t * g1;
        if (F.lane == 0) {
            const unsigned l1 = __hip_atomic_fetch_add((LAS unsigned*)&lcnt[e1], 1u, __ATOMIC_RELAXED, __HIP_MEMORY_SCOPE_WORKGROUP);
            const unsigned l2 = __hip_atomic_fetch_add((LAS unsigned*)&lcnt[e2], 1u, __ATOMIC_RELAXED, __HIP_MEMORY_SCOPE_WORKGROUP);
            rinfo[rl * 8 + 0] = (unsigned)e1; rinfo[rl * 8 + 1] = (unsigned)e2; rinfo[rl * 8 + 2] = l1; rinfo[rl * 8 + 3] = l2;
            rinfo[rl * 8 + 4] = __float_as_uint(g1); rinfo[rl * 8 + 5] = __float_as_uint(g2);
        }
    }
    __syncthreads();
    if (F.tid < 8) lbase[F.tid] = __hip_atomic_fetch_add((unsigned*)(F.ws + WS_CTL) + CW_CNT + F.tid, lcnt[F.tid], RLX_AGENT);
    __syncthreads();
    if (F.tid < 128) { const int rl = F.tid; const unsigned e1 = rinfo[rl * 8], e2 = rinfo[rl * 8 + 1];
        int4 ri; ri.x = (int)e1; ri.y = (int)e2; ri.z = (int)(lbase[e1] + rinfo[rl * 8 + 2]); ri.w = (int)(lbase[e2] + rinfo[rl * 8 + 3]);
        *(int4*)(F.ws + WS_ROUTE + ROUTE_I + (size_t)(rowb + rl) * 16) = ri;
        float2 rg; rg.x = __uint_as_float(rinfo[rl * 8 + 4]); rg.y = __uint_as_float(rinfo[rl * 8 + 5]);
        *(float2*)(F.ws + WS_ROUTE + ROUTE_G + (size_t)(rowb + rl) * 8) = rg; }
    __syncthreads();
}

__device__ __forceinline__ void moe_tiles(const Frame& F, int (&tp)[9]) {
    const unsigned* cnt = (const unsigned*)(F.ws + WS_CTL) + CW_CNT;
    int acc = 0;
#pragma unroll
    for (int e = 0; e < 8; ++e) { tp[e] = acc; const int c = (int)__builtin_amdgcn_readfirstlane(__hip_atomic_load(cnt + e, RLX_AGENT)); acc += (c + 255) >> 8; }
    tp[8] = acc;
}

namespace att {
constexpr int LDS_V = 0, LDS_K = 49152, LDS_BIAS = 98304, LDS_WS = 99328, LDS_OST = 101376, LDS_END = 134144;
static_assert(LDS_END <= RING_BYTES, "attention LDS");
__device__ __forceinline__ int crow(int r, int hi) { return (r & 3) + 8 * (r >> 2) + 4 * hi; }
__device__ __forceinline__ s16x4 vtr(const LAS unsigned char* p) { typedef short v4i16_t __attribute__((ext_vector_type(4))); return __builtin_bit_cast(s16x4, __builtin_amdgcn_ds_read_tr16_b64_v4i16((LAS v4i16_t*)p)); }
__device__ __forceinline__ v2u vtr8(const LAS unsigned char* p) { typedef int v2i32_t __attribute__((ext_vector_type(2))); return __builtin_bit_cast(v2u, __builtin_amdgcn_ds_read_tr8_b64_v2i32((LAS v2i32_t*)p)); }
__device__ __forceinline__ int mod6(int x) { return x >= 6 ? x - 6 : x; }

struct UnitDesc { int r, n2, ub, first; };
__device__ __forceinline__ void glds16(const void* gsrc, unsigned lds_dst) { unsigned keep;
    asm volatile("s_mov_b32 %0, m0\n\ts_mov_b32 m0, %2\n\ts_nop 0\n\tglobal_load_lds_dwordx4 %1, off\n\ts_mov_b32 m0, %0" : "=&s"(keep) : "v"(gsrc), "s"(lds_dst) : "memory"); }
__device__ __forceinline__ unsigned lds_addr(const LAS unsigned char* p) { return (unsigned)__builtin_amdgcn_readfirstlane((int)(unsigned)(uintptr_t)p); }
__device__ __forceinline__ void issue_q(const Frame& F, int dil, int b, int h, const UnitDesc& u, const bf16* Q, v4u (&qw)[2]) {
    const int r32 = F.lane & 31, hi = F.lane >> 5; const size_t qrow = (size_t)(b * 16 + h) * SEQ + (size_t)u.r * (SEQ / dil) + (256 * u.n2 + 32 * F.wave + r32);
#pragma unroll
    for (int j = 0; j < 2; ++j) qw[j] = *(const GAS v4u*)((const unsigned char*)Q + qrow * 64 + hi * 32 + j * 16);
}
__device__ __forceinline__ void issue_k(const Frame& F, int dil, int b, int h, const UnitDesc& u, const bf16* K) {
    const int lane = F.lane, wid = F.wave; const int KB = 256 * u.n2 - 128; const int kl = 16 * (wid & 3) + (lane >> 2);
#pragma unroll
    for (int t = 0; t < 6; ++t) { if (t >= u.first && (t & 1) == (wid >> 2)) {
        int ik = KB + 64 * t + kl; ik = ik < 0 ? 0 : ik;
        const unsigned char* ksrc = (const unsigned char*)K + ((size_t)(b * 16 + h) * SEQ + (size_t)u.r * (SEQ / dil) + ik) * 64 + (lane & 3) * 16;
        glds16(ksrc, lds_addr(F.lds + LDS_K + mod6(u.ub + t) * 8192 + (wid & 3) * 1024)); } }
}
__device__ __forceinline__ void issue_v(const Frame& F, int dil, int b, int h, const UnitDesc& u, const bf16* V) {
    const int lane = F.lane, wid = F.wave; const int KB = 256 * u.n2 - 128;
#pragma unroll
    for (int t = 0; t < 6; ++t) { if (t >= u.first && (t & 1) == (wid >> 2)) {
        int iv = KB + 64 * t + 16 * (wid & 3) + (lane >> 2); iv = iv < 0 ? 0 : iv;
        const unsigned char* vsrc = (const unsigned char*)V + ((size_t)(b * 16 + h) * SEQ + (size_t)u.r * (SEQ / dil) + iv) * 64 + (lane & 3) * 16;
        glds16(vsrc, lds_addr(F.lds + LDS_V + mod6(u.ub + t) * 8192 + (wid & 3) * 1024)); } }
}

template <bool MERGE>
__device__ __forceinline__ void attn_phase(Frame& F, int gi, const bf16* Q, const bf16* K, const bf16* V, bf16* O, float* lse_out, const bf16* O0, const bf16* O1, const float* L0, const float* L1) {
    const int dil = gi == 0 ? 1 : gi == 1 ? 4 : 16, nb2 = 64 / dil;
    const int bh = F.vcu >> 3, s = F.vcu & 7, b = bh >> 4, h = bh & 15;
    const int lane = F.lane, r32 = lane & 31, hi = lane >> 5, wid = F.wave;
    LAS unsigned char* lds = F.lds;
    const size_t rowbase = (size_t)b * SEQ;
    { const float* T = (const float*)(F.ws + WS_TAB + TAB_BIAS) + (size_t)(gi * 16 + h) * 256; if (F.tid < 256) ((LAS float*)(lds + LDS_BIAS))[F.tid] = T[F.tid]; }
    __syncthreads();
    const int T0 = wid >> 1;
    const LAS unsigned char* bl = lds + LDS_BIAS + 4 * (63 - 32 * (wid & 1) - r32 + 4 * hi);
    const int vlane = (4 * hi + (((lane & 15) >> 1) & 3) + 8 * ((lane & 15) >> 3)) * 64 + ((lane >> 4) & 1) * 16 + (lane & 1) * 8;
    LAS float* wsf = (LAS float*)(lds + LDS_WS) + wid * 64;
    LAS bf16* stg = (LAS bf16*)(lds + LDS_OST) + wid * 2048;
    UnitDesc u; { const int idx = s * 8; u.n2 = idx % nb2; u.r = idx / nb2; u.ub = 0; u.first = 0; }
    v4u qw[2];
    issue_q(F, dil, b, h, u, Q, qw); issue_k(F, dil, b, h, u, K);
#pragma unroll 1
    for (int i = 0; i < 8; ++i) {
        const int n2 = u.n2, r = u.r; const int I0 = 256 * n2;
        if (i == 0) asm volatile("s_waitcnt vmcnt(0)" ::: "memory"); else asm volatile("s_waitcnt vmcnt(4)" ::: "memory");
        __builtin_amdgcn_s_barrier();
        asm volatile("" ::: "memory");
        int sl[3];
#pragma unroll
        for (int j = 0; j < 3; ++j) sl[j] = mod6(u.ub + T0 + j) * 8192;
        f32x16 S[6];
#pragma unroll
        for (int tt = 0; tt < 6; ++tt) {
            if ((tt == 0 && (wid & 1)) || (tt == 5 && !(wid & 1))) {
#pragma unroll
                for (int rr = 0; rr < 16; ++rr) S[tt][rr] = -1e30f;
                continue; }
#pragma unroll
            for (int rr = 0; rr < 16; ++rr) S[tt][rr] = *(const LAS float*)(bl + 4 * (32 * tt + (rr & 3) + 8 * (rr >> 2)));
            if (n2 == 0 && 2 * T0 + tt < 4) {
#pragma unroll
                for (int rr = 0; rr < 16; ++rr) S[tt][rr] = -1e30f; }
            const int kk_ = (tt & 1) * 32 + r32; const LAS unsigned char* kp = lds + LDS_K + sl[tt >> 1] + kk_ * 64; const int ksw = (kk_ >> 2) & 3;
            { const v4u kf0 = *(const LAS v4u*)(kp + (((2 * hi) ^ ksw) << 4)), kf1 = *(const LAS v4u*)(kp + (((2 * hi + 1) ^ ksw) << 4));
              typedef int i32x8_t __attribute__((ext_vector_type(8)));
              const i32x8_t ka = __builtin_bit_cast(i32x8_t, __builtin_shufflevector(kf0, kf1, 0, 1, 2, 3, 4, 5, 6, 7)), qb = __builtin_bit_cast(i32x8_t, __builtin_shufflevector(qw[0], qw[1], 0, 1, 2, 3, 4, 5, 6, 7));
              asm volatile("v_mfma_f32_32x32x64_f8f6f4 %0, %1, %2, %0" : "+v"(S[tt]) : "v"(ka), "v"(qb)); }
            if (tt == 1) issue_v(F, dil, b, h, u, V);
        }
        asm volatile("s_nop 15\n\ts_nop 15\n\ts_nop 15\n\ts_nop 15\n\ts_nop 15" ::: "memory");
        __builtin_amdgcn_s_barrier();
        asm volatile("" ::: "memory");
        UnitDesc nu = u;
        if (i + 1 < 8) { const int idx = s * 8 + i + 1; nu.n2 = idx % nb2; nu.r = idx / nb2; const bool cont = (nu.r == r) && (nu.n2 == n2 + 1);
            nu.ub = cont ? mod6(u.ub + 4) : 0; nu.first = cont ? 2 : 0;
            issue_q(F, dil, b, h, nu, Q, qw); issue_k(F, dil, b, h, nu, K); }
        float mx = S[0][0];
#pragma unroll
        for (int tt = 0; tt < 6; ++tt)
#pragma unroll
            for (int rr = 0; rr < 16; ++rr) mx = fmaxf(mx, S[tt][rr]);
        { auto rr = __builtin_amdgcn_permlane32_swap(__float_as_uint(mx), __float_as_uint(mx), false, false); mx = fmaxf(__uint_as_float(rr[0]), __uint_as_float(rr[1])); }
        float lsum = 0.f;
#pragma unroll
        for (int tt = 0; tt < 6; ++tt)
#pragma unroll
            for (int rr = 0; rr < 16; ++rr) { const float p = __builtin_amdgcn_exp2f(S[tt][rr] - mx); S[tt][rr] = p; lsum += p; }
        { auto rr = __builtin_amdgcn_permlane32_swap(__float_as_uint(lsum), __float_as_uint(lsum), false, false); lsum = __uint_as_float(rr[0]) + __uint_as_float(rr[1]); }
        if (i + 1 >= 8) asm volatile("s_waitcnt vmcnt(0)" ::: "memory"); else if (nu.first == 0) asm volatile("s_waitcnt vmcnt(5)" ::: "memory"); else asm volatile("s_waitcnt vmcnt(4)" ::: "memory");
        __builtin_amdgcn_s_barrier();
        asm volatile("" ::: "memory");
        v2u ma[4], mc[4]; float ml0[4], ml1[4];
        if constexpr (MERGE) {
#pragma unroll
            for (int j = 0; j < 4; ++j) { const int row = j * 8 + (lane >> 3); const int tq = (I0 + 32 * wid + row) * dil + r;
                const size_t idh = (size_t)(b * 16 + h) * SEQ + (size_t)(tq & 15) * (SEQ / 16) + (tq >> 4);
                ml0[j] = L0[idh]; ml1[j] = L1[idh]; } }
        f32x16 o[2]; o[0] = f32x16{}; o[1] = f32x16{}; asm volatile("" : "+v"(o[0]), "+v"(o[1]));
#pragma unroll
        for (int pp = 0; pp < 3; ++pp) {
            typedef int i32x8_t __attribute__((ext_vector_type(8)));
            i32x8_t pa;
#pragma unroll
            for (int e = 0; e < 8; ++e) { const int tt = 2 * pp + (e >> 2), j = 4 * (e & 3);
                pa[e] = (int)pk4_fp8(S[tt][j] * 256.f, S[tt][j + 1] * 256.f, S[tt][j + 2] * 256.f, S[tt][j + 3] * 256.f); }
            const LAS unsigned char* vp = lds + LDS_V + sl[pp] + vlane;
#pragma unroll
            for (int d0 = 0; d0 < 2; ++d0) { const v2u v0 = vtr8(vp + d0 * 32), v1 = vtr8(vp + d0 * 32 + 1024), v2 = vtr8(vp + d0 * 32 + 2048), v3 = vtr8(vp + d0 * 32 + 3072);
                const i32x8_t vb = {(int)v0.x, (int)v0.y, (int)v1.x, (int)v1.y, (int)v2.x, (int)v2.y, (int)v3.x, (int)v3.y};
                asm volatile("s_nop 4\n\tv_mfma_f32_32x32x64_f8f6f4 %0, %1, %2, %0" : "+v"(o[d0]) : "v"(pa), "v"(vb)); }
        }
        asm volatile("s_nop 15\n\ts_nop 15\n\ts_nop 15\n\ts_nop 15\n\ts_nop 15" ::: "memory");
        if constexpr (MERGE) {
#pragma unroll
            for (int j = 0; j < 4; ++j) { const int row = j * 8 + (lane >> 3), ch = lane & 7; const int tq = (I0 + 32 * wid + row) * dil + r;
                const size_t offh = ((size_t)(b * 16 + h) * SEQ + (size_t)(tq & 15) * (SEQ / 16) + (tq >> 4)) * 64 + ch * 8;
                ma[j] = *(const GAS v2u*)((const unsigned char*)O0 + offh); mc[j] = *(const GAS v2u*)((const unsigned char*)O1 + offh); } }
        const float lse2 = mx + __builtin_amdgcn_logf(lsum);
        if (hi == 0) { wsf[r32] = lsum; wsf[32 + r32] = lse2; }
        asm volatile("s_waitcnt lgkmcnt(0)" ::: "memory");
#pragma unroll
        for (int rr = 0; rr < 16; ++rr) { const int orow = crow(rr, hi); const float rl = __builtin_amdgcn_rcpf(wsf[orow]) * (1.0f / 4096.f);
#pragma unroll
            for (int d0 = 0; d0 < 2; ++d0) stg[orow * 64 + d0 * 32 + r32] = (bf16)(cvt_pk_bf16(o[d0][rr] * rl, 0.f) & 0xffffu); }
        asm volatile("s_waitcnt lgkmcnt(0)" ::: "memory");
        if constexpr (!MERGE) { if (hi == 0) { const int tq = (I0 + 32 * wid + r32) * dil + r; lse_out[(size_t)(b * 16 + h) * SEQ + (size_t)(tq & 15) * (SEQ / 16) + (tq >> 4)] = lse2; } }
#pragma unroll
        for (int j = 0; j < 4; ++j) { const int row = j * 8 + (lane >> 3), ch = lane & 7;
            const int tq = (I0 + 32 * wid + row) * dil + r; const size_t tok = rowbase + (size_t)tq; const size_t off = tok * D + h * 64 + ch * 8;
            const size_t idh = (size_t)(b * 16 + h) * SEQ + (size_t)(tq & 15) * (SEQ / 16) + (tq >> 4), offh = idh * 64 + ch * 8;
            v4u v = *(const LAS v4u*)(stg + row * 64 + ch * 8);
            if constexpr (MERGE) {
                const float l2 = wsf[32 + row], l0 = ml0[j], l1 = ml1[j];
                const float mm = fmaxf(fmaxf(l0, l1), l2); float w0 = __builtin_amdgcn_exp2f(l0 - mm), w1 = __builtin_amdgcn_exp2f(l1 - mm), w2 = __builtin_amdgcn_exp2f(l2 - mm);
                const float inv = __builtin_amdgcn_rcpf(w0 + w1 + w2); w0 *= inv; w1 *= inv; w2 *= inv;
                const v2u a = ma[j], c = mc[j];
                float mv[8];
#pragma unroll
                for (int e = 0; e < 4; e += 2) {
                    const auto pa0 = __builtin_amdgcn_cvt_pk_f32_fp8((int)a[e >> 1], false), pa1 = __builtin_amdgcn_cvt_pk_f32_fp8((int)a[e >> 1], true);
                    const auto pc0 = __builtin_amdgcn_cvt_pk_f32_fp8((int)c[e >> 1], false), pc1 = __builtin_amdgcn_cvt_pk_f32_fp8((int)c[e >> 1], true);
                    mv[2 * e] = w0 * pa0[0] + w1 * pc0[0] + w2 * SO8 * bf_lo(v[e]); mv[2 * e + 1] = w0 * pa0[1] + w1 * pc0[1] + w2 * SO8 * bf_hi(v[e]);
                    mv[2 * e + 2] = w0 * pa1[0] + w1 * pc1[0] + w2 * SO8 * bf_lo(v[e + 1]); mv[2 * e + 3] = w0 * pa1[1] + w1 * pc1[1] + w2 * SO8 * bf_hi(v[e + 1]); }
                v2u m; m.x = pk4_fp8(mv[0], mv[1], mv[2], mv[3]); m.y = pk4_fp8(mv[4], mv[5], mv[6], mv[7]);
                *(GAS v2u*)((unsigned char*)O + off) = m;
            } else { v2u o8; o8.x = pk4_fp8(bf_lo(v[0]) * SO8, bf_hi(v[0]) * SO8, bf_lo(v[1]) * SO8, bf_hi(v[1]) * SO8); o8.y = pk4_fp8(bf_lo(v[2]) * SO8, bf_hi(v[2]) * SO8, bf_lo(v[3]) * SO8, bf_hi(v[3]) * SO8);
                *(GAS v2u*)((unsigned char*)O + offh) = o8; } }
        asm volatile("s_waitcnt lgkmcnt(0)" ::: "memory");
        __builtin_amdgcn_s_barrier();
        asm volatile("" ::: "memory");
        u = nu;
    }
}
}

__device__ __forceinline__ void moe_slots_scatter(Frame& F) {
    const int gw = F.vcu * NWAVES + F.wave, NGW = F.G * NWAVES;
    int tp[9]; moe_tiles(F, tp);
    { int* slot_tok = (int*)(F.ws + WS_ROUTE + ROUTE_ST);
      for (int t = blockIdx.x * NTHREADS + F.tid; t < M; t += F.G * NTHREADS) { const int4 ri = *(const int4*)(F.ws + WS_ROUTE + ROUTE_I + (size_t)t * 16);
          int o1 = 0, o2 = 0;
#pragma unroll
          for (int e = 0; e < 8; ++e) { if (ri.x == e) o1 = tp[e]; if (ri.y == e) o2 = tp[e]; }
          slot_tok[o1 * 256 + ri.z] = t * 2; slot_tok[o2 * 256 + ri.w] = t * 2 + 1; } }
    { const unsigned char* xq = (const unsigned char*)(F.ws + WS_X3Q); unsigned char* xg = (unsigned char*)(F.ws + WS_XG);
      for (int t0 = gw * 4; t0 < M; t0 += NGW * 4) { v4u a[4]; int s1[4], s2[4];
#pragma unroll
          for (int j = 0; j < 4; ++j) { const int4 ri = *(const int4*)(F.ws + WS_ROUTE + ROUTE_I + (size_t)(t0 + j) * 16); int o1 = 0, o2 = 0;
#pragma unroll
              for (int e = 0; e < 8; ++e) { if (ri.x == e) o1 = tp[e]; if (ri.y == e) o2 = tp[e]; }
              s1[j] = o1 * 256 + ri.z; s2[j] = o2 * 256 + ri.w; a[j] = *(const GAS v4u*)(xq + (size_t)(t0 + j) * D + F.lane * 16); }
#pragma unroll
          for (int j = 0; j < 4; ++j) { *(GAS v4u*)(xg + (size_t)s1[j] * D + F.lane * 16) = a[j]; *(GAS v4u*)(xg + (size_t)s2[j] * D + F.lane * 16) = a[j]; } } }
}
__device__ __forceinline__ void moe_gather(Frame& F, int lo, int hi) {
    const int gw = F.vcu * NWAVES + F.wave, NGW = F.G * NWAVES;
    const int* slot_tok = (const int*)(F.ws + WS_ROUTE + ROUTE_ST); const unsigned char* xq = (const unsigned char*)(F.ws + WS_X3Q); unsigned char* xg = (unsigned char*)(F.ws + WS_XG);
    const int n = (hi - lo) * 256;
    for (int s0 = gw * 4; s0 < n; s0 += NGW * 4) {
        int st[4]; v4u a[4];
#pragma unroll
        for (int j = 0; j < 4; ++j) st[j] = (s0 + j < n) ? slot_tok[lo * 256 + s0 + j] : -1;
#pragma unroll
        for (int j = 0; j < 4; ++j) { a[j] = (v4u){0u, 0u, 0u, 0u}; if (st[j] >= 0) a[j] = *(const GAS v4u*)(xq + (size_t)(st[j] >> 1) * D + F.lane * 16); }
#pragma unroll
        for (int j = 0; j < 4; ++j) if (s0 + j < n) *(GAS v4u*)(xg + (size_t)(s0 + j) * D + F.lane * 16) = a[j]; }
}
__device__ __forceinline__ void final_late_row(const bf16* part, int slot, int lane, f32x4 (&y)[4]) {
    const int rt = slot >> 8, sr = slot & 255;
#pragma unroll
    for (int j = 0; j < 4; ++j) { f32x4 a = {0.f, 0.f, 0.f, 0.f};
#pragma unroll
        for (int ck = 0; ck < 7; ++ck) { const v2u w = *(const GAS v2u*)(part + ((size_t)(((rt - 256) * 4 + j) * 7 + ck) << 16) + (size_t)sr * 256 + lane * 4);
            a += (f32x4){pg8::bf_lo(w.x), pg8::bf_hi(w.x), pg8::bf_lo(w.y), pg8::bf_hi(w.y)}; }
        y[j] = a; }
}
__device__ __forceinline__ void final_pass(Frame& F, float* out, const float* gam, const float* bet) {
    const int gw = F.vcu * NWAVES + F.wave, NGW = F.G * NWAVES;
    f32x4 gv[4], bv[4];
#pragma unroll
    for (int j = 0; j < 4; ++j) { gv[j] = *(const GAS f32x4*)(gam + F.lane * 4 + 256 * j); bv[j] = *(const GAS f32x4*)(bet + F.lane * 4 + 256 * j); }
    const bf16* xb = (const bf16*)(F.ws + WS_X3B);
    int tp[9]; moe_tiles(F, tp);
    const bf16* part = (const bf16*)(F.ws + WS_XG);
    for (int row0 = gw; row0 < M; row0 += 2 * NGW) {
        v2u xw[2][4], y1[2][4], y2[2][4]; float2 rg[2]; int4 ri[2];
#pragma unroll
        for (int t = 0; t < 2; ++t) { const int row = row0 + t * NGW; if (row < M) {
            rg[t] = *(const float2*)(F.ws + WS_ROUTE + ROUTE_G + (size_t)row * 8); ri[t] = *(const int4*)(F.ws + WS_ROUTE + ROUTE_I + (size_t)row * 16);
            const bf16* yrow = (const bf16*)(out + (size_t)row * D);
#pragma unroll
            for (int j = 0; j < 4; ++j) { xw[t][j] = *(const GAS v2u*)(xb + (size_t)row * D + F.lane * 4 + 256 * j); y1[t][j] = *(const GAS v2u*)(yrow + F.lane * 4 + 256 * j); y2[t][j] = *(const GAS v2u*)(yrow + D + F.lane * 4 + 256 * j); } } }
#pragma unroll
        for (int t = 0; t < 2; ++t) { const int row = row0 + t * NGW; if (row < M) {
            f32x4 v[4], ya[4], yb[4];
#pragma unroll
            for (int j = 0; j < 4; ++j) { ya[j] = (f32x4){bf_lo(y1[t][j].x), bf_hi(y1[t][j].x), bf_lo(y1[t][j].y), bf_hi(y1[t][j].y)}; yb[j] = (f32x4){bf_lo(y2[t][j].x), bf_hi(y2[t][j].x), bf_lo(y2[t][j].y), bf_hi(y2[t][j].y)}; }
            { int o1 = 0, o2 = 0;
#pragma unroll
              for (int e = 0; e < 8; ++e) { if (ri[t].x == e) o1 = tp[e]; if (ri[t].y == e) o2 = tp[e]; }
              const int sl1 = __builtin_amdgcn_readfirstlane(o1 * 256 + ri[t].z), sl2 = __builtin_amdgcn_readfirstlane(o2 * 256 + ri[t].w);
              if (sl1 >= 65536) final_late_row(part, sl1, F.lane, ya);
              if (sl2 >= 65536) final_late_row(part, sl2, F.lane, yb); }
#pragma unroll
            for (int j = 0; j < 4; ++j) {
                const f32x4 xf = {bf_lo(xw[t][j].x), bf_hi(xw[t][j].x), bf_lo(xw[t][j].y), bf_hi(xw[t][j].y)};
                v[j] = ALPHA * xf + rg[t].x * ya[j] + rg[t].y * yb[j]; }
            float mean, rstd; ln_stats(v, mean, rstd);
#pragma unroll
            for (int j = 0; j < 4; ++j) { const f32x4 y = (v[j] - mean) * rstd * gv[j] + bv[j]; *(GAS f32x4*)(out + (size_t)row * D + F.lane * 4 + 256 * j) = y; } } }
    }
}

template <int GI> __device__ __forceinline__ void phase_att(Frame& F) {
    const bf16* Qp = (const bf16*)(F.ws + WS_Q); const bf16* Kp = (const bf16*)(F.ws + WS_K); const bf16* Vp = (const bf16*)(F.ws + WS_V);
    const bf16* O0 = (const bf16*)(F.ws + WS_O0); const bf16* O1 = (const bf16*)(F.ws + WS_O1); float* L0 = (float*)(F.ws + WS_LSE); float* L1 = L0 + (size_t)M * 16;
    if constexpr (GI < 2) att::attn_phase<false>(F, GI, Qp, Kp, Vp, (bf16*)(F.ws + (GI == 0 ? WS_O0 : WS_O1)), GI == 0 ? L0 : L1, O0, O1, L0, L1);
    else att::attn_phase<true>(F, GI, Qp, Kp, Vp, (bf16*)(F.ws + WS_MQ), nullptr, O0, O1, L0, L1);
}
template <int RR> __device__ __forceinline__ void moe_round(const Frame& F, int (&tp)[9], int& rlo, int& rhi) {
    moe_tiles(F, tp); rlo = 0; rhi = tp[8];
}
constexpr int ULIST_OFF = LDSCTL_OFF + 256, ULIST_MAX = 1024;
__device__ __forceinline__ int build_unit_list(Frame& F, const int (&tp)[9], int rlo, int rhi, int nN) {
    const int ntot = (rhi - rlo) * nN; const int c = (int)blockIdx.x;
    int n = c < ntot ? (ntot - c + F.G - 1) / F.G : 0; n = n > ULIST_MAX ? ULIST_MAX : n;
    LAS unsigned* list = (LAS unsigned*)(F.lds + ULIST_OFF);
    for (int i = F.tid; i < n; i += NTHREADS) list[i] = pg8::grouped_unit(tp, rlo, rhi, nN, (long)i * F.G + c);
    __syncthreads();
    return __builtin_amdgcn_readfirstlane(n);
}
template <int RR> __device__ __forceinline__ void phase_moe_gather(Frame& F) { int tp[9], rlo, rhi; moe_round<RR>(F, tp, rlo, rhi); moe_gather(F, rlo, rhi); }
template <int RR> __device__ __forceinline__ void phase_moe1(Frame& F) {
    int tp[9], rlo, rhi; moe_round<RR>(F, tp, rlo, rhi);
    const int n = build_unit_list(F, tp, rlo, rhi, 2 * DFE / 256);
    pg8::Gemm g{(const bf16*)(F.ws + WS_XG), (const bf16*)(F.ws + WM_13), 0, 0, D / 2}; pg8::ListOrder S{(const LAS unsigned*)(F.lds + ULIST_OFF), n};
    pg8::EpiSwiGLU8 E{(unsigned char*)(F.ws + WS_H), DFE, 2 * DFE / 256, 1.0f / (SX8 * SW13_8), SH8};
    pg8::gemm_phase<pg8::EpiSwiGLU8, pg8::ListOrder, true, true, true>(F.lds, g, S, E);
}
constexpr int MOE2_KCH = 4, MOE2_NCH = 7;
static_assert(MOE2_KCH * MOE2_NCH * 128 == DFE && (MAXTILES - 256) * 4 * MOE2_NCH <= 256, "MoE-2 K chunks");
template <int RR> __device__ __forceinline__ void phase_moe2(Frame& F, float* out) {
    int tp[9]; moe_tiles(F, tp);
    const int T = tp[8], nmain = (T < 256 ? T : 256) * (D / 256), c = (int)blockIdx.x;
    LAS unsigned* list = (LAS unsigned*)(F.lds + ULIST_OFF);
    int n = c < nmain ? (nmain - c + F.G - 1) / F.G : 0;
    for (int i = F.tid; i < n; i += NTHREADS) list[i] = pg8::grouped_unit(tp, 0, T < 256 ? T : 256, D / 256, (long)i * F.G + c);
    const int ntail = (T > 256 ? T - 256 : 0) * (D / 256);
    if (c < ntail * MOE2_NCH) { const int tu = c / MOE2_NCH, ck = c % MOE2_NCH, rt = 256 + (tu >> 2), ct = tu & 3; int e = 0;
#pragma unroll
        for (int q = 1; q < 8; ++q) if (rt >= tp[q]) e = q;
        if (F.tid == 0) list[n] = (unsigned)rt | ((unsigned)(e * (D / 256) + ct) << 16) | ((unsigned)(ck + 1) << 24);
        ++n; }
    __syncthreads();
    n = __builtin_amdgcn_readfirstlane(n);
    pg8::Gemm g{(const bf16*)(F.ws + WS_H), (const bf16*)(F.ws + WM_2), 0, 0, DFE / 2}; pg8::ListOrder S{(const LAS unsigned*)(F.lds + ULIST_OFF), n};
    pg8::EpiMoE2 E{(bf16*)out, (const int*)(F.ws + WS_ROUTE + ROUTE_ST), D / 256, 1.0f / (SH8 * SW2_8), (bf16*)(F.ws + WS_XG)};
    pg8::gemm_phase<pg8::EpiMoE2, pg8::ListOrder, true, true, true, MOE2_KCH>(F.lds, g, S, E);
}

template <int K> __device__ __forceinline__ void run_phase(Frame& F, float* out_) {
    bf16* const xb0 = (bf16*)(F.ws + WS_XB0); bf16* const x1b = (bf16*)(F.ws + WS_X1B); bf16* const x2b = (bf16*)(F.ws + WS_X2B); bf16* const x3b = (bf16*)(F.ws + WS_X3B);
    bf16* const Z = (bf16*)(F.ws + WS_Z); bf16* const Z2 = (bf16*)(F.ws + WS_Z2); bf16* const Z2B = (bf16*)(F.ws + WS_Z2B);
    pg8::stat_t* const ST1 = (pg8::stat_t*)(F.ws + WS_ST); pg8::stat_t* const ST2 = ST1 + (size_t)M;
    float* const cv13 = (float*)(F.ws + WS_TAB + TAB_CV13); float* const dv13 = cv13 + 2 * DFF; float* const cvq = (float*)(F.ws + WS_TAB + TAB_CVQKV); float* const dvq = cvq + 9 * D;
    if constexpr (K == 0) p0_prologue<0>(F);
    else if constexpr (K == 1) {
        pg8::Gemm g{xb0, (const bf16*)(F.ws + W_IN), M, D, D / 2}; pg8::StaticOrder S; S.init(M, D, F.G, (int)blockIdx.x);
        pg8::EpiU E{(bf16*)(F.ws + WS_U), 1.0f / (SX8 * SWI8)};
        pg8::gemm_phase<pg8::EpiU, pg8::StaticOrder, true, true, true>(F.lds, g, S, E);
    } else if constexpr (K == 2) {
        s5_phase<false>(F); }
    else if constexpr (K == 3) s5_phase<true>(F);
    else if constexpr (K == 4) {
        pg8::Gemm g{(const bf16*)(F.ws + WS_YB), (const bf16*)(F.ws + W_GLU), M, 2 * D, D / 2}; pg8::StaticOrder S; S.init(M, 2 * D, F.G, (int)blockIdx.x);
        pg8::EpiGLU E{INP(0), Z, ALPHA, 1.f, 1.0f / (SY8 * SWG8), ST1};
        pg8::gemm_phase<pg8::EpiGLU, pg8::StaticOrder, true, true, true>(F.lds, g, S, E);
    } else if constexpr (K == 5) { }
    else if constexpr (K == 6) {
        pg8::Gemm g{Z, (const bf16*)(F.ws + W_13), M, 2 * DFF, D}; pg8::StaticOrder S; S.init(M, 2 * DFF, F.G, (int)blockIdx.x);
        pg8::EpiSwiGLUf<FFN_DOWN_FP8 != 0> E{(bf16*)(F.ws + WS_HF), DFF, ST1, cv13, dv13};
        pg8::gemm_phase<pg8::EpiSwiGLUf<FFN_DOWN_FP8 != 0>, pg8::StaticOrder, true, true>(F.lds, g, S, E);
    } else if constexpr (K == 7) {
#if FFN_DOWN_FP8
        pg8::Gemm g{(const bf16*)(F.ws + WS_HF), (const bf16*)(F.ws + W_2), M, D, DFF / 2}; pg8::StaticOrder S; S.init(M, D, F.G, (int)blockIdx.x);
        pg8::EpiResidF E{Z, ST1, INP(21), INP(22), Z2B, (unsigned char*)(F.ws + WS_X2Q), ST2, ALPHA, 1.0f / (8.f * 2048.f)};
        pg8::gemm_phase<pg8::EpiResidF, pg8::StaticOrder, true, true, true>(F.lds, g, S, E);
#else
        pg8::Gemm g{(const bf16*)(F.ws + WS_HF), (const bf16*)(F.ws + W_2), M, D, DFF}; pg8::StaticOrder S; S.init(M, D, F.G, (int)blockIdx.x);
        pg8::EpiResidF E{Z, ST1, INP(21), INP(22), Z2B, (unsigned char*)(F.ws + WS_X2Q), ST2, ALPHA, 1.f};
        pg8::gemm_phase<pg8::EpiResidF, pg8::StaticOrder, true, true>(F.lds, g, S, E);
#endif
    } else if constexpr (K == 8) { }
    else if constexpr (K == 9 || K == 11 || K == 13) {
        constexpr int gi = (K - 9) / 2;
        pg8::Gemm g{(const bf16*)(F.ws + WS_X2Q), (const bf16*)(F.ws + W_QKV + (size_t)gi * 3 * D * D), M, 3 * D, D / 2}; pg8::StaticOrder S; S.init(M, 3 * D, F.G, (int)blockIdx.x);
        pg8::EpiQKV E{(bf16*)(F.ws + WS_Q), (size_t)(WS_K - WS_Q) / 2, 1.0f / (SX8 * SWQ8), ST2, cvq + gi * 3 * D, dvq + gi * 3 * D, 2 * gi};
        pg8::gemm_phase<pg8::EpiQKV, pg8::StaticOrder, true, true, true>(F.lds, g, S, E);
    } else if constexpr (K == 10 || K == 12 || K == 14) phase_att<(K - 10) / 2>(F);
    else if constexpr (K == 15) {
        pg8::Gemm g{(const bf16*)(F.ws + WS_MQ), (const bf16*)(F.ws + W_O), M, D, D / 2}; pg8::StaticOrder S; S.init(M, D, F.G, (int)blockIdx.x);
        pg8::EpiResidF E{Z2B, ST2, INP(21) + D, INP(22) + D, Z2, nullptr, nullptr, ALPHA, 1.0f / (SO8 * SWO8)};
        pg8::gemm_phase<pg8::EpiResidF, pg8::StaticOrder, true, true, true>(F.lds, g, S, E);
    } else if constexpr (K == 16) ln_router_pass(F, Z2, INP(21) + 2 * D, INP(22) + 2 * D, INP(17), x3b, (unsigned char*)(F.ws + WS_X3Q));
    else if constexpr (K == 17) moe_slots_scatter(F);
    else if constexpr (K == 18) { }
    else if constexpr (K == 19) phase_moe1<0>(F);
    else if constexpr (K == 20) phase_moe2<0>(F, out_);
    else if constexpr (K == 21) final_pass(F, out_, INP(21) + 3 * D, INP(22) + 3 * D);
}

template <int K> __device__ __forceinline__ void seam_work(Frame& F) {
    LAS float* scr = (LAS float*)(F.lds + F.wave * TR_SCR_BYTES);
    const int gw = F.vcu * NWAVES + F.wave, NGW = F.G * NWAVES;
    int cur = 0;
    float* const cv13 = (float*)(F.ws + WS_TAB + TAB_CV13); float* const dv13 = cv13 + 2 * DFF; float* const cvq = (float*)(F.ws + WS_TAB + TAB_CVQKV); float* const dvq = cvq + 9 * D;
    auto moe_w2 = [&](int e) { transpose_matrix<true>(INP(20) + (size_t)e * DFE * D, DFE, D, D, (void*)(F.ws + WM_2 + (size_t)e * D * DFE), 0, 0, SW2_8, nullptr, scr, F.lane, gw, NGW, cur); };
    auto moe_w1 = [&](int e) { transpose_matrix<true>(INP(18) + (size_t)e * D * DFE, D, DFE, DFE, (void*)(F.ws + WM_13 + (size_t)e * 2 * DFE * D), 1, 0, SW13_8, nullptr, scr, F.lane, gw, NGW, cur); };
    auto moe_w3 = [&](int e) { transpose_matrix<true>(INP(19) + (size_t)e * D * DFE, D, DFE, DFE, (void*)(F.ws + WM_13 + (size_t)e * 2 * DFE * D), 1, 1, SW13_8, nullptr, scr, F.lane, gw, NGW, cur); };
    auto wqkv = [&](int g) { transpose_matrix<true>(INP(11) + g * 3 * D, D, 3 * D, 9 * D, (void*)(F.ws + W_QKV + (size_t)g * 3 * D * D), 2, 0, SWQ8, INP(21) + D, scr, F.lane, gw, NGW, cur); };
    if constexpr (K == 0) p0_prologue<1>(F);
    else if constexpr (K == 1) {
        transpose_matrix(INP(14), D, DFF, DFF, (bf16*)(F.ws + W_13), 1, 0, 1.0f, INP(21), scr, F.lane, gw, NGW, cur);
        transpose_matrix(INP(15), D, DFF, DFF, (bf16*)(F.ws + W_13), 1, 1, 1.0f, INP(21), scr, F.lane, gw, NGW, cur); }
    else if constexpr (K == 2) { wqkv(0); wqkv(1); }
    else if constexpr (K == 3) { wqkv(2); colvec_pass<false>(F, (const void*)(F.ws + W_13), 2 * DFF, 1.0f, INP(21), INP(22), cv13, dv13); }
    else if constexpr (K == 4) {
#if FFN_DOWN_FP8
        transpose_matrix<true>(INP(16), DFF, D, D, (void*)(F.ws + W_2), 0, 0, 2048.f, nullptr, scr, F.lane, gw, NGW, cur);
#else
        transpose_matrix(INP(16), DFF, D, D, (bf16*)(F.ws + W_2), 0, 0, 1.0f, nullptr, scr, F.lane, gw, NGW, cur);
#endif
        transpose_matrix<true>(INP(12), D, D, D, (void*)(F.ws + W_O), 0, 0, SWO8, nullptr, scr, F.lane, gw, NGW, cur); }
    else if constexpr (K == 6) colvec_pass<true>(F, (const void*)(F.ws + W_QKV), 9 * D, 1.0f / SWQ8, INP(21) + D, INP(22) + D, cvq, dvq);
    else if constexpr (K == 7) { moe_w2(0); moe_w1(0); }
    else if constexpr (K == 9) { moe_w2(1); moe_w3(0); }
    else if constexpr (K == 10) { moe_w2(2); moe_w1(1); }
    else if constexpr (K == 11) { moe_w2(3); moe_w3(1); }
    else if constexpr (K == 12) { moe_w2(4); moe_w1(2); }
    else if constexpr (K == 13) { moe_w2(5); moe_w3(2); moe_w1(3); }
    else if constexpr (K == 14) { moe_w2(6); moe_w3(3); moe_w1(4); moe_w3(4); }
    else if constexpr (K == 15) { moe_w1(5); moe_w3(5); moe_w1(6); }
    else if constexpr (K == 16) { moe_w3(6); moe_w1(7); moe_w3(7); }
    else if constexpr (K == 17) moe_w2(7);
}

struct Args { In in; float* out; unsigned char* ws; int ph_lo, ph_hi; };
__global__ void __launch_bounds__(NTHREADS, 2) mk_fwd(Args args) {
    extern __shared__ __attribute__((aligned(16))) unsigned char lds_raw[];
    Frame F;
    F.lds = (LAS unsigned char*)lds_raw; F.ws = args.ws; float* const out_ = args.out;
    F.tid = threadIdx.x; F.lane = F.tid & 63; F.wave = __builtin_amdgcn_readfirstlane(F.tid >> 6);
    F.G = gridDim.x; { const int bx = blockIdx.x; F.vcu = (F.G % 8 == 0) ? (bx % 8) * (F.G / 8) + bx / 8 : bx; }
    for (int u = F.tid; u < (LDS_BYTES - LDSCTL_OFF) / 4; u += NTHREADS) ((LAS unsigned*)(F.lds + LDSCTL_OFF))[u] = 0u;
    __syncthreads();
    unsigned* ctl = (unsigned*)(F.ws + WS_CTL);
    XcdBarrier bar; bar.bar = ctl + CW_BAR; bar.x = 0; bar.st = nullptr;
#if !MK_SPLIT
    bar = xcd_barrier_post(ctl + CW_BAR, (volatile LAS unsigned*)(F.lds + LDSCTL_OFF));
#endif
    const int lo = args.ph_lo, hi = args.ph_hi;
#ifndef PH_MASK
#define PH_MASK 0x3fffffu
#endif
#define IN(k) (((PH_MASK >> (k)) & 1u) && lo <= (k) && (k) < hi)
#if MK_SPLIT
#define SEAM(k) do { } while (0)
#else
#define SEAM(k) do { if ((k) + 1 < hi) xcd_barrier(bar); } while (0)
#endif
#define RUN(k) if (IN(k)) { run_phase<k>(F, out_); SEAM(k); }
#if MK_SPLIT
#define RUNW(k) if (IN(k)) { run_phase<k>(F, out_); seam_work<k>(F); }
#else
#define RUNW(k) if (IN(k)) { run_phase<k>(F, out_); xcd_barrier_arrive(bar); seam_work<k>(F); xcd_barrier_wait(bar); }
#endif
    RUNW(0) RUNW(1) RUNW(2) RUNW(3) RUNW(4) RUNW(6) RUNW(7) RUNW(9) RUNW(10) RUNW(11) RUNW(12) RUNW(13) RUNW(14) RUNW(15) RUNW(16) RUNW(17) RUN(19) RUN(20)
    if (IN(21)) { run_phase<21>(F, out_); }
#undef RUN
#undef RUNW
#undef IN
#undef SEAM
}

extern "C" void kernel_launch(void* const* d_in, const int* in_sizes, int n_in, void* d_out, int out_size, void* d_ws, size_t ws_size, hipStream_t stream) {
    static int grid = 0;
    if (grid == 0) {
        if (n_in != 23 || in_sizes[0] != M * D || out_size != M * D || ws_size < WS_END) { fprintf(stderr, "kernel_launch: unexpected shapes / workspace (n_in %d, in0 %d, out %d, ws %zu, need %zu)\n", n_in, n_in > 0 ? in_sizes[0] : -1, out_size, ws_size, (size_t)WS_END); grid = -1; return; }
        int dev = 0, cus = 0, per_cu = 0;
        if (hipGetDevice(&dev) != hipSuccess || hipDeviceGetAttribute(&cus, hipDeviceAttributeMultiprocessorCount, dev) != hipSuccess) { grid = -1; return; }
        if (hipFuncSetAttribute((const void*)mk_fwd, hipFuncAttributeMaxDynamicSharedMemorySize, LDS_BYTES) != hipSuccess) { fprintf(stderr, "kernel_launch: hipFuncSetAttribute failed\n"); grid = -1; return; }
        if (hipOccupancyMaxActiveBlocksPerMultiprocessor(&per_cu, (const void*)mk_fwd, NTHREADS, LDS_BYTES) != hipSuccess || per_cu < 1) fprintf(stderr, "kernel_launch: occupancy query says %d\n", per_cu);
        (void)hipGetLastError();
        grid = cus;
        if (grid != 256) { fprintf(stderr, "kernel_launch: built for 256 CUs, device has %d\n", cus); grid = -1; return; }
    }
    if (grid < 0) return;
    if (hipMemsetAsync((char*)d_ws + WS_CTL, 0, CTL_ZERO_BYTES, stream) != hipSuccess) return;
    if (hipMemsetAsync((char*)d_ws + WS_ST, 0, ST_BYTES, stream) != hipSuccess) return;
    Args a{};
    for (int i = 0; i < 23; ++i) a.in.p[i] = (const float*)d_in[i];
    a.out = (float*)d_out; a.ws = (unsigned char*)d_ws;
#if MK_SPLIT
    for (int p = 0; p < NPHASE; ++p) { a.ph_lo = p; a.ph_hi = p + 1; hipLaunchKernelGGL(mk_fwd, dim3(grid), dim3(NTHREADS), LDS_BYTES, stream, a); }
#else
    a.ph_lo = 0; a.ph_hi = NPHASE;
    hipLaunchKernelGGL(mk_fwd, dim3(grid), dim3(NTHREADS), LDS_BYTES, stream, a);
#endif
}
```

```cpp
#include <hip/hip_runtime.h>
#include <cstdio>
#include <cstdint>
#include <cmath>

#ifndef FFN_DOWN_FP8
#define FFN_DOWN_FP8 1
#endif
#ifndef MK_SPLIT
#define MK_SPLIT 0
#endif

namespace pg8 {
#define PG8_LAS __attribute__((address_space(3)))
typedef unsigned short bf16_t;
typedef short bf16x8 __attribute__((ext_vector_type(8)));
typedef float f32x4 __attribute__((ext_vector_type(4)));
typedef float f32x2 __attribute__((ext_vector_type(2)));
typedef unsigned u32x4 __attribute__((ext_vector_type(4)));
typedef unsigned u32x2 __attribute__((ext_vector_type(2)));
constexpr int BM = 256, BK = 64, HALF = 128, HTB = HALF * BK * 2, STAGE_BYTES = 8 * HTB, NXCD = 8, WGM = 8;

__host__ __device__ __forceinline__ int lds_byte(int r, int c) { const int st = (r >> 4) * 2 + (c >> 5), rr = r & 15, cc = c & 31, ob = rr * 64 + cc * 2; return st * 1024 + (ob ^ (((ob >> 9) & 1) << 5)); }
__host__ __device__ __forceinline__ void stage_rc(int b, int& R, int& C) { const int st = b / 1024, sb = b % 1024, swz = sb ^ (((sb >> 9) & 1) << 5); R = (st >> 1) * 16 + swz / 64; C = (st & 1) * 32 + (swz % 64) / 2; }
__host__ __device__ __forceinline__ int perm32(int rho) { const int n = rho >> 4, i = rho & 15; return 8 * (i >> 2) + 4 * n + (i & 3); }

struct Unit { int pm, pn, kc; };
struct Gemm { const bf16_t* A; const bf16_t* Bt; int M, N, K; };

struct StaticOrder {
    int nM, nN, nwg, G, c;
    __host__ __device__ void init(int M, int N, int G_, int c_) { nM = M / BM; nN = N / BM; nwg = nM * nN; G = G_; c = c_; }
    __host__ __device__ bool next(int i, Unit& u) const {
        const long L = (long)i * G + c; if (L >= nwg) return false;
        int wgid = (int)L; { const int q = nwg / NXCD, r = nwg % NXCD, xcd = wgid % NXCD, off = wgid / NXCD; wgid = (xcd < r ? xcd * (q + 1) : r * (q + 1) + (xcd - r) * q) + off; }
        const int nig = WGM * nN, gid = wgid / nig, fm = gid * WGM, gsz = (nM - fm) < WGM ? (nM - fm) : WGM;
        u.pm = fm + ((wgid % nig) % gsz); u.pn = (wgid % nig) / gsz; u.kc = 0; return true;
    }
    __device__ __forceinline__ void a_ready(const Unit&) const {}
    __device__ __forceinline__ void done(const Unit&) const {}
};

struct ListOrder {
    const PG8_LAS unsigned* list; int n;
    __device__ __forceinline__ bool next(int i, Unit& u) const { if (i >= n) return false; const unsigned w = (unsigned)__builtin_amdgcn_readfirstlane((int)list[i]); u.pm = (int)(w & 0xffffu); u.pn = (int)((w >> 16) & 0xffu); u.kc = (int)(w >> 24); return true; }
    __device__ __forceinline__ void a_ready(const Unit&) const {}
    __device__ __forceinline__ void done(const Unit&) const {}
};
__device__ __forceinline__ unsigned grouped_unit(const int (&tp)[9], int lo, int hi, int nN, long L) {
    const int ntot = (hi - lo) * nN;
    int w = (int)L; { const int q = ntot / NXCD, r = ntot % NXCD, xcd = w % NXCD, off = w / NXCD; w = (xcd < r ? xcd * (q + 1) : r * (q + 1) + (xcd - r) * q) + off; }
    int s_lo = 0, s_nt = 1, s_e = 0; bool found = false;
#pragma unroll
    for (int e = 0; e < 8; ++e) { const int a = tp[e], b = tp[e + 1]; const int l_ = a > lo ? a : lo, h_ = b < hi ? b : hi; const int nt_ = h_ > l_ ? h_ - l_ : 0; const int nu_ = nt_ * nN;
        if (!found) { if (w < nu_) { found = true; s_lo = l_; s_nt = nt_; s_e = e; } else w -= nu_; } }
    const int nig = WGM * nN, gid = w / nig, fm = gid * WGM, gsz = (s_nt - fm) < WGM ? (s_nt - fm) : WGM;
    const int pm = s_lo - lo + fm + ((w % nig) % gsz), pn = s_e * nN + (w % nig) / gsz;
    return (unsigned)pm | ((unsigned)pn << 16);
}

typedef __bf16 bf16x2_t __attribute__((ext_vector_type(2)));
__device__ __forceinline__ unsigned cvt_pk_bf16(float lo, float hi) { f32x2 v = {lo, hi}; bf16x2_t b = __builtin_convertvector(v, bf16x2_t); return __builtin_bit_cast(unsigned, b); }
__device__ __forceinline__ float clamp8(float x) { return __builtin_amdgcn_fmed3f(x, -440.f, 440.f); }
__device__ __forceinline__ unsigned pk4_fp8(float a, float b, float c, float d) { int r = __builtin_amdgcn_cvt_pk_fp8_f32(clamp8(a), clamp8(b), 0, false); r = __builtin_amdgcn_cvt_pk_fp8_f32(clamp8(c), clamp8(d), r, true); return (unsigned)r; }
__device__ __forceinline__ float bf_lo(unsigned w) { return __uint_as_float(w << 16); }
__device__ __forceinline__ float bf_hi(unsigned w) { return __uint_as_float(w & 0xffff0000u); }
__device__ __forceinline__ float sigmoidf_fast(float x) { return __builtin_amdgcn_rcpf(1.0f + __builtin_amdgcn_exp2f(-1.4426950408889634f * x)); }
typedef long long stat_t;
__device__ __forceinline__ void row_stats(const stat_t* ST, int row, float& mean, float& rstd) {
    const stat_t w = ST[row]; const float fs = (float)(int)(w >> 32) * (1.0f / 65536.0f), fq2 = (float)(unsigned)(w & 0xffffffffll) * (1.0f / 4096.0f);
    mean = fs * (1.0f / 1024.0f); const float var = fmaxf(fq2 * (1.0f / 1024.0f) - mean * mean, 0.f); rstd = __builtin_amdgcn_rsqf(var + 1e-5f);
}
__device__ __forceinline__ void add_row_stats4(stat_t* ST, int rowb, int fr, int fq, const float (&s)[4], const float (&q)[4]) {
    float ts = 0.f, tq = 0.f;
#pragma unroll
    for (int m = 0; m < 4; ++m) { float a = s[m], b = q[m]; a += __shfl_xor(a, 16); a += __shfl_xor(a, 32); b += __shfl_xor(b, 16); b += __shfl_xor(b, 32); if (fq == m) { ts = a; tq = b; } }
    const stat_t w = (stat_t)((unsigned long long)(unsigned)__float2int_rn(ts * 65536.0f) << 32) + (stat_t)(unsigned)__float2uint_rn(tq * 4096.0f);
    atomicAdd((unsigned long long*)(ST + rowb + 16 * fq + fr), (unsigned long long)w);
}

struct EpiQKV {
    static constexpr bool PERM = true, AFTER_DRAIN = false;
    bf16_t* O; size_t stride; float sc; const stat_t* ST; const float* cv; const float* dv; int ldil;
    __device__ __forceinline__ void operator()(const f32x4 (&acc)[2][2][4][2], const Unit& u, int wr, int wc, int fr, int fq) const {
        const int row0 = u.pm * BM + wr * 64 + fr; const int t = u.pn >> 2;
        bf16_t* base = O + (size_t)t * stride + (wc & 1) * 32 + 8 * fq;
        const int hd0 = (u.pn & 3) * 4 + (wc >> 1);
        f32x4 cc[2][2], dd[2][2];
#pragma unroll
        for (int bj = 0; bj < 2; ++bj)
#pragma unroll
            for (int n = 0; n < 2; ++n) { cc[bj][n] = *(const f32x4*)(cv + u.pn * BM + bj * HALF + wc * 32 + 8 * fq + 4 * n); dd[bj][n] = *(const f32x4*)(dv + u.pn * BM + bj * HALF + wc * 32 + 8 * fq + 4 * n); }
#pragma unroll
        for (int ai = 0; ai < 2; ++ai)
#pragma unroll
            for (int m = 0; m < 4; ++m) { const int row = row0 + ai * HALF + m * 16; const int bb = row >> 14, tok = row & 16383;
                const size_t rn = (size_t)(tok & ((1 << ldil) - 1)) * (16384 >> ldil) + (tok >> ldil);
                float mean, rstd; row_stats(ST, row, mean, rstd);
#pragma unroll
                for (int bj = 0; bj < 2; ++bj) { f32x4 v0 = (acc[ai][bj][m][0] * sc - cc[bj][0] * mean) * rstd + dd[bj][0], v1 = (acc[ai][bj][m][1] * sc - cc[bj][1] * mean) * rstd + dd[bj][1];
                    const size_t rowi = (size_t)(bb * 16 + hd0 + bj * 2) * 16384 + rn;
                    if (t < 3) {
                        const float s8 = t == 0 ? 8.f : t == 1 ? 0.125f : 16.f; v0 = v0 * s8; v1 = v1 * s8; u32x2 q8; q8.x = pk4_fp8(v0[0], v0[1], v0[2], v0[3]); q8.y = pk4_fp8(v1[0], v1[1], v1[2], v1[3]);
                        const int c8 = (wc & 1) * 4 + fq, p8 = t == 2 ? c8 : (c8 & 1) * 4 + (c8 >> 1), sw = t == 1 ? (int)((tok >> ldil) >> 2) & 3 : 0;
                        *(u32x2*)((unsigned char*)O + (size_t)t * stride * 2 + rowi * 64 + (((p8 >> 1) ^ sw) << 4) + ((p8 & 1) << 3)) = q8;
                    } else {
                        u32x4 w; w.x = cvt_pk_bf16(v0[0], v0[1]); w.y = cvt_pk_bf16(v0[2], v0[3]); w.z = cvt_pk_bf16(v1[0], v1[1]); w.w = cvt_pk_bf16(v1[2], v1[3]);
                        *(u32x4*)(base + rowi * 64) = w; } } }
    }
};
struct EpiU {
    static constexpr bool PERM = true, AFTER_DRAIN = false;
    bf16_t* U; float sc;
    __device__ __forceinline__ void operator()(const f32x4 (&acc)[2][2][4][2], const Unit& u, int wr, int wc, int fr, int fq) const {
        const int row0 = u.pm * BM + wr * 64 + fr; const int col0 = u.pn * BM + wc * 32 + 8 * fq;
#pragma unroll
        for (int ai = 0; ai < 2; ++ai)
#pragma unroll
            for (int m = 0; m < 4; ++m) { const int row = row0 + ai * HALF + m * 16; const int b = row >> 14, t = row & 16383;
#pragma unroll
                for (int bj = 0; bj < 2; ++bj) { const int col = col0 + bj * HALF; const int g = col >> 4, c = col & 15;
                    const f32x4 v0 = acc[ai][bj][m][0] * sc, v1 = acc[ai][bj][m][1] * sc;
                    u32x4 w; w.x = cvt_pk_bf16(v0[0], v0[1]); w.y = cvt_pk_bf16(v0[2], v0[3]); w.z = cvt_pk_bf16(v1[0], v1[1]); w.w = cvt_pk_bf16(v1[2], v1[3]);
                    *(u32x4*)(U + (((size_t)(b * 64 + g) * 16384 + t) * 16 + c)) = w; } }
    }
};
struct EpiGLU {
    static constexpr bool PERM = true, AFTER_DRAIN = false;
    const float* X; bf16_t* Z; float alpha; float gain; float sc; stat_t* ST;
    __device__ __forceinline__ void operator()(const f32x4 (&acc)[2][2][4][2], const Unit& u, int wr, int wc, int fr, int fq) const {
        const int row0 = u.pm * BM + wr * 64 + fr; const int col0 = u.pn * HALF + wc * 32 + 8 * fq;
#pragma unroll
        for (int ai = 0; ai < 2; ++ai) { float s4[4], q4[4];
#pragma unroll
            for (int m = 0; m < 4; ++m) { const size_t off = (size_t)(row0 + ai * HALF + m * 16) * 1024 + col0; float z[8]; float ssum = 0.f, ssq = 0.f;
#pragma unroll
                for (int n = 0; n < 2; ++n) { const f32x4 v = acc[ai][0][m][n] * sc, gt = acc[ai][1][m][n] * sc; const f32x4 x = *(const f32x4*)(X + off + 4 * n);
#pragma unroll
                    for (int i = 0; i < 4; ++i) { const float zz = alpha * x[i] + gain * (v[i] * sigmoidf_fast(gt[i])); z[4 * n + i] = zz; ssum += zz; ssq += zz * zz; } }
                s4[m] = ssum; q4[m] = ssq;
                u32x4 w; w.x = cvt_pk_bf16(z[0], z[1]); w.y = cvt_pk_bf16(z[2], z[3]); w.z = cvt_pk_bf16(z[4], z[5]); w.w = cvt_pk_bf16(z[6], z[7]);
                *(u32x4*)(Z + off) = w; }
            add_row_stats4(ST, u.pm * BM + wr * 64 + ai * HALF, fr, fq, s4, q4); }
    }
};
struct EpiSwiGLU {
    static constexpr bool PERM = true, AFTER_DRAIN = false;
    bf16_t* H; int ldh; int ntn;
    __device__ __forceinline__ void operator()(const f32x4 (&acc)[2][2][4][2], const Unit& u, int wr, int wc, int fr, int fq) const {
        const int row0 = u.pm * BM + wr * 64 + fr; const int col0 = (u.pn % ntn) * HALF + wc * 32 + 8 * fq;
#pragma unroll
        for (int ai = 0; ai < 2; ++ai)
#pragma unroll
            for (int m = 0; m < 4; ++m) { bf16_t* p = H + (size_t)(row0 + ai * HALF + m * 16) * ldh + col0;
                float h[8];
#pragma unroll
                for (int n = 0; n < 2; ++n) { const f32x4 a = acc[ai][0][m][n], b = acc[ai][1][m][n];
#pragma unroll
                    for (int i = 0; i < 4; ++i) h[4 * n + i] = a[i] * sigmoidf_fast(a[i]) * b[i]; }
                u32x4 w; w.x = cvt_pk_bf16(h[0], h[1]); w.y = cvt_pk_bf16(h[2], h[3]); w.z = cvt_pk_bf16(h[4], h[5]); w.w = cvt_pk_bf16(h[6], h[7]);
                *(u32x4*)p = w; }
    }
};
struct EpiSwiGLU8 {
    static constexpr bool PERM = true, AFTER_DRAIN = false;
    unsigned char* H; int ldh; int ntn; float sin, sout;
    __device__ __forceinline__ void operator()(const f32x4 (&acc)[2][2][4][2], const Unit& u, int wr, int wc, int fr, int fq) const {
        const int row0 = u.pm * BM + wr * 64 + fr; const int col0 = (u.pn % ntn) * HALF + wc * 32 + 8 * fq;
        const float cinv = 1.0f / (sin * sin * sout), lcinv = __builtin_log2f(cinv);
#pragma unroll
        for (int ai = 0; ai < 2; ++ai)
#pragma unroll
            for (int m = 0; m < 4; ++m) { unsigned char* p = H + (size_t)(row0 + ai * HALF + m * 16) * ldh + col0;
                float h[8];
#pragma unroll
                for (int n = 0; n < 2; ++n) { const f32x4 a = acc[ai][0][m][n], b = acc[ai][1][m][n];
#pragma unroll
                    for (int i = 0; i < 4; ++i) h[4 * n + i] = a[i] * b[i] * __builtin_amdgcn_rcpf(cinv + __builtin_amdgcn_exp2f(__builtin_fmaf(a[i], -1.4426950408889634f * sin, lcinv))); }
                u32x2 w; w.x = pk4_fp8(h[0], h[1], h[2], h[3]); w.y = pk4_fp8(h[4], h[5], h[6], h[7]);
                *(u32x2*)p = w; }
    }
};
struct EpiResid {
    static constexpr bool PERM = false, AFTER_DRAIN = false;
    const bf16_t* XB; bf16_t* Z; float alpha; float gain;
    __device__ __forceinline__ void operator()(const f32x4 (&acc)[2][2][4][2], const Unit& u, int wr, int wc, int fr, int fq) const {
        const int row0 = u.pm * BM + wr * 64 + fr; const int col0 = u.pn * BM + wc * 32 + 4 * fq;
#pragma unroll
        for (int ai = 0; ai < 2; ++ai)
#pragma unroll
            for (int m = 0; m < 4; ++m) { const size_t off = (size_t)(row0 + ai * HALF + m * 16) * 1024 + col0;
#pragma unroll
                for (int bj = 0; bj < 2; ++bj)
#pragma unroll
                    for (int n = 0; n < 2; ++n) { const u32x2 xw = *(const u32x2*)(XB + off + bj * HALF + n * 16); const f32x4 a = acc[ai][bj][m][n];
                        u32x2 z; z.x = cvt_pk_bf16(alpha * bf_lo(xw.x) + gain * a[0], alpha * bf_hi(xw.x) + gain * a[1]); z.y = cvt_pk_bf16(alpha * bf_lo(xw.y) + gain * a[2], alpha * bf_hi(xw.y) + gain * a[3]);
                        *(u32x2*)(Z + off + bj * HALF + n * 16) = z; } }
    }
};
template <bool OUT8> struct EpiSwiGLUf {
    static constexpr bool PERM = true, AFTER_DRAIN = false;
    bf16_t* H; int ldh; const stat_t* ST; const float* cv; const float* dv;
    __device__ __forceinline__ void operator()(const f32x4 (&acc)[2][2][4][2], const Unit& u, int wr, int wc, int fr, int fq) const {
        const int row0 = u.pm * BM + wr * 64 + fr; const int jc = wc * 32 + 8 * fq; const int col0 = u.pn * HALF + jc;
        f32x4 ca[2], cb[2], da[2], db[2];
#pragma unroll
        for (int n = 0; n < 2; ++n) { ca[n] = *(const f32x4*)(cv + u.pn * BM + jc + 4 * n); cb[n] = *(const f32x4*)(cv + u.pn * BM + HALF + jc + 4 * n);
            da[n] = *(const f32x4*)(dv + u.pn * BM + jc + 4 * n); db[n] = *(const f32x4*)(dv + u.pn * BM + HALF + jc + 4 * n); }
#pragma unroll
        for (int ai = 0; ai < 2; ++ai)
#pragma unroll
            for (int m = 0; m < 4; ++m) { const int row = row0 + ai * HALF + m * 16; float mean, rstd; row_stats(ST, row, mean, rstd);
                float h[8];
#pragma unroll
                for (int n = 0; n < 2; ++n) { const f32x4 a = (acc[ai][0][m][n] - ca[n] * mean) * rstd + da[n], b = (acc[ai][1][m][n] - cb[n] * mean) * rstd + db[n];
#pragma unroll
                    for (int i = 0; i < 4; ++i) h[4 * n + i] = OUT8 ? a[i] * b[i] * __builtin_amdgcn_rcpf(0.125f + __builtin_amdgcn_exp2f(__builtin_fmaf(a[i], -1.4426950408889634f, -3.0f))) : a[i] * sigmoidf_fast(a[i]) * b[i]; }
                if constexpr (OUT8) { u32x2 w8; w8.x = pk4_fp8(h[0], h[1], h[2], h[3]); w8.y = pk4_fp8(h[4], h[5], h[6], h[7]); *(u32x2*)((unsigned char*)H + (size_t)row * ldh + col0) = w8; }
                else { u32x4 w; w.x = cvt_pk_bf16(h[0], h[1]); w.y = cvt_pk_bf16(h[2], h[3]); w.z = cvt_pk_bf16(h[4], h[5]); w.w = cvt_pk_bf16(h[6], h[7]);
                    *(u32x4*)(H + (size_t)row * ldh + col0) = w; } }
    }
};
struct EpiResidF {
    static constexpr bool PERM = true, AFTER_DRAIN = false;
    const bf16_t* Zin; const stat_t* STin; const float* gam; const float* bet; bf16_t* Zout; unsigned char* Zq; stat_t* STout; float alpha; float gain;
    __device__ __forceinline__ void operator()(const f32x4 (&acc)[2][2][4][2], const Unit& u, int wr, int wc, int fr, int fq) const {
        const int row0 = u.pm * BM + wr * 64 + fr; const int col0 = u.pn * BM + wc * 32 + 8 * fq;
        f32x4 g[2][2], bb[2][2];
#pragma unroll
        for (int bj = 0; bj < 2; ++bj)
#pragma unroll
            for (int n = 0; n < 2; ++n) { g[bj][n] = *(const f32x4*)(gam + col0 + bj * HALF + 4 * n); bb[bj][n] = *(const f32x4*)(bet + col0 + bj * HALF + 4 * n); }
#pragma unroll
        for (int ai = 0; ai < 2; ++ai) { float s4[4], q4[4];
#pragma unroll
            for (int m = 0; m < 4; ++m) { const int row = row0 + ai * HALF + m * 16; const size_t off = (size_t)row * 1024 + col0; float mean, rstd; row_stats(STin, row, mean, rstd);
                float ssum = 0.f, ssq = 0.f;
#pragma unroll
                for (int bj = 0; bj < 2; ++bj) { const u32x4 zw = *(const u32x4*)(Zin + off + bj * HALF); float zo[8];
#pragma unroll
                    for (int n = 0; n < 2; ++n) { const f32x4 a = acc[ai][bj][m][n]; const unsigned w0 = zw[2 * n], w1 = zw[2 * n + 1];
                        const f32x4 zi = {bf_lo(w0), bf_hi(w0), bf_lo(w1), bf_hi(w1)};
                        const f32x4 x = (zi - mean) * rstd * g[bj][n] + bb[bj][n]; const f32x4 z = x * alpha + a * gain;
#pragma unroll
                        for (int i = 0; i < 4; ++i) { zo[4 * n + i] = z[i]; ssum += z[i]; ssq += z[i] * z[i]; } }
                    u32x4 w; w.x = cvt_pk_bf16(zo[0], zo[1]); w.y = cvt_pk_bf16(zo[2], zo[3]); w.z = cvt_pk_bf16(zo[4], zo[5]); w.w = cvt_pk_bf16(zo[6], zo[7]);
                    *(u32x4*)(Zout + off + bj * HALF) = w;
                    if (Zq) { u32x2 q8; q8.x = pk4_fp8(zo[0] * 16.f, zo[1] * 16.f, zo[2] * 16.f, zo[3] * 16.f); q8.y = pk4_fp8(zo[4] * 16.f, zo[5] * 16.f, zo[6] * 16.f, zo[7] * 16.f); *(u32x2*)(Zq + off + bj * HALF) = q8; } }
                s4[m] = ssum; q4[m] = ssq; }
            if (STout) add_row_stats4(STout, u.pm * BM + wr * 64 + ai * HALF, fr, fq, s4, q4); }
    }
};
struct EpiMoE2 {
    static constexpr bool PERM = true, AFTER_DRAIN = false;
    bf16_t* Y; const int* slot_tok; int ntn; float sc; bf16_t* PART;
    __device__ __forceinline__ void operator()(const f32x4 (&acc)[2][2][4][2], const Unit& u, int wr, int wc, int fr, int fq) const {
        if (u.kc) {
            bf16_t* tile = PART + ((size_t)(((u.pm - 256) * 4 + (u.pn % ntn)) * 7 + (u.kc - 1)) << 16) + (size_t)(wr * 64 + fr) * 256 + wc * 32 + 8 * fq;
#pragma unroll
            for (int ai = 0; ai < 2; ++ai)
#pragma unroll
                for (int m = 0; m < 4; ++m)
#pragma unroll
                    for (int bj = 0; bj < 2; ++bj) { const f32x4 v0 = acc[ai][bj][m][0] * sc, v1 = acc[ai][bj][m][1] * sc;
                        u32x4 w; w.x = cvt_pk_bf16(v0[0], v0[1]); w.y = cvt_pk_bf16(v0[2], v0[3]); w.z = cvt_pk_bf16(v1[0], v1[1]); w.w = cvt_pk_bf16(v1[2], v1[3]);
                        *(u32x4*)(tile + (size_t)(ai * HALF + m * 16) * 256 + bj * HALF) = w; }
            return; }
        const int row0 = u.pm * BM + wr * 64 + fr; const int col0 = (u.pn % ntn) * BM + wc * 32 + 8 * fq;
#pragma unroll
        for (int ai = 0; ai < 2; ++ai)
#pragma unroll
            for (int m = 0; m < 4; ++m) { const int st = slot_tok[row0 + ai * HALF + m * 16];
                if (st >= 0) { bf16_t* rowp = Y + (size_t)st * 1024 + col0;
#pragma unroll
                    for (int bj = 0; bj < 2; ++bj) { const f32x4 v0 = acc[ai][bj][m][0] * sc, v1 = acc[ai][bj][m][1] * sc;
                        u32x4 w; w.x = cvt_pk_bf16(v0[0], v0[1]); w.y = cvt_pk_bf16(v0[2], v0[3]); w.z = cvt_pk_bf16(v1[0], v1[1]); w.w = cvt_pk_bf16(v1[2], v1[3]);
                        *(u32x4*)(rowp + bj * HALF) = w; } } }
    }
};

typedef int i32x8 __attribute__((ext_vector_type(8)));
template <class Epi, class Sched, bool ALIGN_EPI = false, bool SP2 = false, bool FP8 = false, int KCH_T = 0>
__device__ __forceinline__ void gemm_phase(PG8_LAS unsigned char* lds, const Gemm g, const Sched& S, const Epi& E) {
    const int tid = threadIdx.x, wid = __builtin_amdgcn_readfirstlane(tid >> 6), lane = tid & 63, wr = wid >> 2, wc = wid & 3, fr = lane & 15, fq = lane >> 4;
    const int K = g.K, nt = K / BK;
    unsigned voffA[2], voffB[2];
#pragma unroll
    for (int i = 0; i < 2; ++i) { int R, C; stage_rc(tid * 16 + i * 8192, R, C); const int Rb = Epi::PERM ? ((R & ~31) + perm32(R & 31)) : R;
        voffA[i] = (unsigned)(R * K + C) * 2u; voffB[i] = (unsigned)(Rb * K + C) * 2u; }
    const size_t kstep = (size_t)(BK * 2);
    const size_t hstep = (size_t)HALF * K * 2;
    const size_t tstep = 2 * hstep;
    const unsigned ldsw = (unsigned)wid * 1024u;
    const int aoff = lds_byte(wr * 64 + fr, fq * 8), boff = lds_byte(wc * 32 + fr, fq * 8);
#define PG8_SA(b, h) (((b) * 2 + (h)) * HTB)
#define PG8_SB(b, h) ((4 + (b) * 2 + (h)) * HTB)
#define PG8_STAGE(bufoff, gbase, voff) do { _Pragma("unroll") for (int _i = 0; _i < 2; ++_i) \
        __builtin_amdgcn_global_load_lds((const unsigned*)((const char*)(gbase) + (voff)[_i]), (PG8_LAS unsigned*)(lds + (bufoff) + ldsw + _i * 8192), 16, 0, 0); } while (0)
#define PG8_LDA(dst, b, h) do { _Pragma("unroll") for (int m = 0; m < 4; ++m) _Pragma("unroll") for (int k = 0; k < 2; ++k) dst[m][k] = *(const PG8_LAS bf16x8*)(lds + PG8_SA(b, h) + aoff + m * 2048 + k * 1024); } while (0)
#define PG8_LDB(dst, b, h) do { _Pragma("unroll") for (int n = 0; n < 2; ++n) _Pragma("unroll") for (int k = 0; k < 2; ++k) dst[n][k] = *(const PG8_LAS bf16x8*)(lds + PG8_SB(b, h) + boff + n * 2048 + k * 1024); } while (0)
#define PG8_CAT(x) __builtin_shufflevector(__builtin_bit_cast(u32x4, (x)[0]), __builtin_bit_cast(u32x4, (x)[1]), 0, 1, 2, 3, 4, 5, 6, 7)
#define PG8_MMA(ai, bj, At, Bt) do { __builtin_amdgcn_s_setprio(1); _Pragma("unroll") for (int m = 0; m < 4; ++m) _Pragma("unroll") for (int n = 0; n < 2; ++n) { \
        if constexpr (FP8) { const i32x8 b8_ = __builtin_bit_cast(i32x8, PG8_CAT(Bt[n])), a8_ = __builtin_bit_cast(i32x8, PG8_CAT(At[m])); \
            asm volatile("v_mfma_scale_f32_16x16x128_f8f6f4 %0, %1, %2, %0, %3, %3 op_sel_hi:[0,0,0]" : "+v"(acc[ai][bj][m][n]) : "v"(b8_), "v"(a8_), "v"(sc127)); } \
        else { _Pragma("unroll") for (int k = 0; k < 2; ++k) acc[ai][bj][m][n] = __builtin_amdgcn_mfma_f32_16x16x32_bf16(Bt[n][k], At[m][k], acc[ai][bj][m][n], 0, 0, 0); } } \
        __builtin_amdgcn_s_setprio(0); } while (0)
#define PG8_WAIT_V(n) asm volatile("s_waitcnt vmcnt(" #n ")" ::: "memory")
#define PG8_WAIT_L(n) asm volatile("s_waitcnt lgkmcnt(" #n ")" ::: "memory")
#define PG8_BAR __builtin_amdgcn_s_barrier()
#define PG8_SCHED __builtin_amdgcn_sched_barrier(0)
    Unit cur, nxt; int ui = 0;
    if (!S.next(0, cur)) return;
    int sc127 = 127; asm volatile("" : "+v"(sc127));
    f32x4 acc[2][2][4][2];
#pragma unroll
    for (int a = 0; a < 2; ++a)
#pragma unroll
        for (int b = 0; b < 2; ++b)
#pragma unroll
            for (int m = 0; m < 4; ++m)
#pragma unroll
                for (int n = 0; n < 2; ++n) { acc[a][b][m][n] = (f32x4){0.f, 0.f, 0.f, 0.f}; }
    bf16x8 At[4][2], B0[2][2], B1[2][2];
    const char* cA = (const char*)g.A + (size_t)cur.pm * tstep; const char* cB = (const char*)g.Bt + (size_t)cur.pn * tstep;
    int ntu = nt;
    if constexpr (KCH_T > 0) { if (cur.kc) { const size_t ko = (size_t)(cur.kc - 1) * KCH_T * kstep; cA += ko; cB += ko; ntu = KCH_T; } }
    S.a_ready(cur);
    if constexpr (SP2) {
        PG8_STAGE(PG8_SB(0, 0), cB, voffB); PG8_STAGE(PG8_SB(0, 1), cB + hstep, voffB); PG8_STAGE(PG8_SA(0, 0), cA, voffA); PG8_STAGE(PG8_SA(0, 1), cA + hstep, voffA);
        if (wr == 1) PG8_BAR;
        PG8_WAIT_V(2); PG8_BAR;
        PG8_STAGE(PG8_SB(1, 0), cB + kstep, voffB); PG8_STAGE(PG8_SA(1, 0), cA + kstep, voffA); PG8_STAGE(PG8_SB(1, 1), cB + hstep + kstep, voffB);
        PG8_WAIT_V(6); PG8_BAR;
    } else {
        PG8_STAGE(PG8_SB(0, 0), cB, voffB); PG8_STAGE(PG8_SA(0, 0), cA, voffA); PG8_STAGE(PG8_SB(0, 1), cB + hstep, voffB); PG8_STAGE(PG8_SA(0, 1), cA + hstep, voffA);
        if (wr == 1) PG8_BAR;
        PG8_WAIT_V(4); PG8_BAR;
        PG8_STAGE(PG8_SB(1, 0), cB + kstep, voffB); PG8_STAGE(PG8_SA(1, 0), cA + kstep, voffA); PG8_STAGE(PG8_SB(1, 1), cB + hstep + kstep, voffB);
        PG8_WAIT_V(6); PG8_BAR;
    }
    for (;;) {
        const bool has_next = S.next(ui + 1, nxt);
        const char* nA = has_next ? (const char*)g.A + (size_t)nxt.pm * tstep : cA; const char* nB = has_next ? (const char*)g.Bt + (size_t)nxt.pn * tstep : cB;
        int ntn_ = nt;
        if constexpr (KCH_T > 0) { if (has_next && nxt.kc) { const size_t ko = (size_t)(nxt.kc - 1) * KCH_T * kstep; nA += ko; nB += ko; ntn_ = KCH_T; } }
        for (int t = 0; t < ntu; t += 2) {
            const bool last = (t == ntu - 2);
            const char* a1 = cA + (size_t)(t + 1) * kstep;
            const char* a2 = last ? nA : cA + (size_t)(t + 2) * kstep; const char* b2 = last ? nB : cB + (size_t)(t + 2) * kstep;
            const char* a3 = a2 + kstep; const char* b3 = b2 + kstep;
            if (last && has_next) S.a_ready(nxt);
            if constexpr (SP2) {
            PG8_LDB(B0, 0, 0); PG8_LDB(B1, 0, 1); PG8_SCHED; PG8_LDA(At, 0, 0); PG8_STAGE(PG8_SA(1, 1), a1 + hstep, voffA);
            PG8_WAIT_V(8); PG8_WAIT_L(0); PG8_BAR; PG8_MMA(0, 0, At, B0); PG8_MMA(0, 1, At, B1); PG8_BAR; PG8_SCHED;
            PG8_LDA(At, 0, 1); PG8_STAGE(PG8_SB(0, 0), b2, voffB); PG8_STAGE(PG8_SB(0, 1), b2 + hstep, voffB); PG8_STAGE(PG8_SA(0, 0), a2, voffA);
            PG8_WAIT_V(8); PG8_WAIT_L(0); PG8_BAR; PG8_MMA(1, 0, At, B0); PG8_MMA(1, 1, At, B1); PG8_BAR; PG8_SCHED;
            PG8_LDB(B0, 1, 0); PG8_LDB(B1, 1, 1); PG8_SCHED; PG8_LDA(At, 1, 0); PG8_STAGE(PG8_SA(0, 1), a2 + hstep, voffA);
            PG8_WAIT_V(8); PG8_WAIT_L(0); PG8_BAR; PG8_MMA(0, 0, At, B0); PG8_MMA(0, 1, At, B1); PG8_BAR; PG8_SCHED;
            PG8_LDA(At, 1, 1); PG8_STAGE(PG8_SB(1, 0), b3, voffB); PG8_STAGE(PG8_SB(1, 1), b3 + hstep, voffB); PG8_STAGE(PG8_SA(1, 0), a3, voffA);
            PG8_WAIT_V(8); PG8_WAIT_L(0); PG8_BAR; PG8_MMA(1, 0, At, B0); PG8_MMA(1, 1, At, B1); PG8_BAR; PG8_SCHED;
            } else {
            PG8_LDB(B0, 0, 0); PG8_SCHED; PG8_LDA(At, 0, 0); PG8_STAGE(PG8_SA(1, 1), a1 + hstep, voffA);
            PG8_WAIT_L(8); PG8_BAR; PG8_WAIT_L(0); PG8_MMA(0, 0, At, B0); PG8_BAR; PG8_SCHED;
            PG8_LDB(B1, 0, 1); PG8_STAGE(PG8_SB(0, 0), b2, voffB);
            PG8_BAR; PG8_WAIT_L(0); PG8_MMA(0, 1, At, B1); PG8_BAR;
            PG8_LDA(At, 0, 1); PG8_STAGE(PG8_SA(0, 0), a2, voffA);
            PG8_BAR; PG8_WAIT_L(0); PG8_MMA(1, 0, At, B0); PG8_BAR; PG8_SCHED;
            PG8_STAGE(PG8_SB(0, 1), b2 + hstep, voffB);
            PG8_WAIT_V(6); PG8_BAR; PG8_MMA(1, 1, At, B1); PG8_BAR;
            PG8_LDB(B0, 1, 0); PG8_SCHED; PG8_LDA(At, 1, 0); PG8_STAGE(PG8_SA(0, 1), a2 + hstep, voffA);
            PG8_WAIT_L(8); PG8_BAR; PG8_WAIT_L(0); PG8_MMA(0, 0, At, B0); PG8_BAR; PG8_SCHED;
            PG8_LDB(B1, 1, 1); PG8_STAGE(PG8_SB(1, 0), b3, voffB);
            PG8_BAR; PG8_WAIT_L(0); PG8_MMA(0, 1, At, B1); PG8_BAR;
            PG8_LDA(At, 1, 1); PG8_STAGE(PG8_SA(1, 0), a3, voffA);
            PG8_BAR; PG8_WAIT_L(0); PG8_MMA(1, 0, At, B0); PG8_BAR; PG8_SCHED;
            PG8_STAGE(PG8_SB(1, 1), b3 + hstep, voffB);
            PG8_WAIT_V(6); PG8_BAR; PG8_MMA(1, 1, At, B1); PG8_BAR;
            }
        }
        if constexpr (ALIGN_EPI) { if (wr == 0) PG8_BAR; }
        if constexpr (FP8) asm volatile("s_nop 15\n\ts_nop 7" ::: "memory");
        if constexpr (!Epi::AFTER_DRAIN) { E(acc, cur, wr, wc, fr, fq); S.done(cur); }
        if (!has_next) break;
#pragma unroll
        for (int a = 0; a < 2; ++a)
#pragma unroll
            for (int b = 0; b < 2; ++b)
#pragma unroll
                for (int m = 0; m < 4; ++m)
#pragma unroll
                    for (int n = 0; n < 2; ++n) { acc[a][b][m][n] = (f32x4){0.f, 0.f, 0.f, 0.f}; }
        cur = nxt; cA = nA; cB = nB; ntu = ntn_; ++ui;
        if constexpr (ALIGN_EPI) { if (wr == 1) PG8_BAR; }
    }
    PG8_WAIT_V(0);
    if constexpr (!ALIGN_EPI) { if (wr == 0) PG8_BAR; }
    PG8_BAR;
#undef PG8_SA
#undef PG8_SB
#undef PG8_STAGE
#undef PG8_LDA
#undef PG8_LDB
#undef PG8_MMA
#undef PG8_CAT
#undef PG8_WAIT_V
#undef PG8_WAIT_L
#undef PG8_BAR
#undef PG8_SCHED
}
}

typedef unsigned short bf16;
typedef unsigned v4u __attribute__((ext_vector_type(4)));
typedef unsigned v2u __attribute__((ext_vector_type(2)));
typedef float f32x4 __attribute__((ext_vector_type(4)));
typedef float f32x16 __attribute__((ext_vector_type(16)));
typedef short bf16x8 __attribute__((ext_vector_type(8)));
typedef short s16x4 __attribute__((ext_vector_type(4)));
#define GAS __attribute__((address_space(1)))
#define LAS __attribute__((address_space(3)))
typedef GAS unsigned gu32;

constexpr int NWAVES = 8, NTHREADS = 512;
constexpr int NB = 2, SEQ = 16384, D = 1024, M = NB * SEQ;
constexpr int DFF = 2816, NE = 8, DFE = 3584;
constexpr float ALPHA = 1.4142135623730951f, LN_EPS = 1e-5f;
constexpr float LOG2E = 1.4426950408889634f;
constexpr float QSCALE = 0.125f * LOG2E;
constexpr int NPHASE = 22;
constexpr float SX8 = 16.f, SWQ8 = 256.f, SW13_8 = 256.f, SW2_8 = 2048.f, SH8 = 8.f, SY8 = 8.f, SWG8 = 256.f, SWI8 = 256.f, SO8 = 64.f, SWO8 = 512.f;

constexpr size_t MiB = 1u << 20;
constexpr size_t WS_CTL = 0, CTL_ZERO_BYTES = 1 * MiB;
constexpr size_t WS_TAB = 1 * MiB;
constexpr size_t TAB_BB = 0, TAB_CC = 256 * 1024, TAB_AB = 576 * 1024, TAB_BIAS = 704 * 1024, TAB_CV13 = 768 * 1024, TAB_CVQKV = 832 * 1024;
constexpr size_t WS_ROUTE = 2 * MiB;
constexpr size_t ROUTE_I = 0, ROUTE_G = 512 * 1024, ROUTE_ST = 768 * 1024;
constexpr int MAXTILES = 264, MAXSLOT = MAXTILES * 256, RTILES = 132;
constexpr size_t WS_E = 4 * MiB;
constexpr size_t WS_LSE = 5 * MiB;
constexpr size_t WS_W = 10 * MiB;
constexpr size_t W_IN = WS_W, W_GLU = WS_W + 2 * MiB, W_13 = WS_W + 6 * MiB, W_2 = WS_W + 17 * MiB, W_QKV = WS_W + 23 * MiB, W_O = 533 * MiB;
constexpr size_t WM_13 = WS_W, WM_2 = 505 * MiB;
constexpr size_t WS_XB0 = 56 * MiB, WS_U = 120 * MiB, WS_YB = 184 * MiB, WS_Z = 248 * MiB, WS_X1B = 376 * MiB, WS_HF = 56 * MiB, WS_X2B = 440 * MiB;
constexpr size_t WS_Q = 56 * MiB, WS_K = 120 * MiB, WS_V = 184 * MiB, WS_O0 = 248 * MiB, WS_O1 = 312 * MiB, WS_Z2 = 184 * MiB, WS_X3B = 94 * MiB, WS_X2Q = 376 * MiB, WS_X3Q = 408 * MiB, WS_MQ = 376 * MiB;
constexpr size_t WS_XG = 190 * MiB, WS_H = 256 * MiB, WS_Z2B = 440 * MiB, WS_ST = 504 * MiB, ST_BYTES = 2 * (size_t)M * 8, WS_END = 534 * MiB;
static_assert(WS_H + (size_t)MAXTILES * 256 * DFE <= WS_ST && WS_XG + (size_t)MAXTILES * 256 * D <= WS_H && WM_13 + (size_t)NE * 2 * DFE * D <= WS_X3B && WM_2 + (size_t)NE * D * DFE <= W_O && W_O + (size_t)D * D <= WS_END && WS_ST + ST_BYTES <= WM_2, "moe buffers");
constexpr int CW_CNT = 64;
constexpr int CW_BAR = 4096;

constexpr int RING_BYTES = 139264;
constexpr int LDSCTL_OFF = RING_BYTES;
constexpr int LDS_BYTES = 147456;

#define RLX_AGENT __ATOMIC_RELAXED, __HIP_MEMORY_SCOPE_AGENT
#define VM_WAIT() asm volatile("s_waitcnt vmcnt(0)" ::: "memory")
#define LDS_WAIT() asm volatile("s_waitcnt lgkmcnt(0)" ::: "memory")
using pg8::cvt_pk_bf16; using pg8::bf_lo; using pg8::bf_hi; using pg8::pk4_fp8;

#define XB_TMO      128
#define XB_XCNT(j)  (256  + 64 * (j))
#define XB_XSUB(j)  (1280 + 64 * (j))
#define XB_XGEN(j)  (2304 + 64 * (j))
#define XB_TOP      3328
#define XB_TOPGEN   3392
#define XCD_BAR_WORDS 3456
#define XB_SPIN_CAP (1u << 18)
__device__ __forceinline__ unsigned xb_ld(unsigned* p)              { return __hip_atomic_load(p, __ATOMIC_RELAXED, __HIP_MEMORY_SCOPE_AGENT); }
__device__ __forceinline__ unsigned xb_add(unsigned* p, unsigned v) { return __hip_atomic_fetch_add(p, v, __ATOMIC_RELAXED, __HIP_MEMORY_SCOPE_AGENT); }
__device__ __forceinline__ unsigned xb_xcc_id() { return (unsigned)__builtin_amdgcn_s_getreg((3 << 11) | 20) & 0xFu; }
#define XB_SPIN(cond, bar) do { unsigned _sp = 0; while (cond) { __builtin_amdgcn_s_sleep(1); \
    if ((++_sp & 255u) == 0u) { if (xb_ld(&(bar)[XB_TMO])) break; if (_sp > XB_SPIN_CAP) { atomicAdd(&(bar)[XB_TMO], 1u); break; } } } } while (0)
struct XcdBarrier { unsigned* bar; unsigned x; volatile LAS unsigned* st; };
__device__ __forceinline__ XcdBarrier xcd_barrier_post(unsigned* bar, volatile LAS unsigned* st) {
    XcdBarrier b; b.bar = bar; b.x = xb_xcc_id(); b.st = st;
    if (threadIdx.x == 0) (void)xb_add(&bar[XB_XCNT(b.x)], 1u);
    return b;
}
__device__ __forceinline__ void xcd_barrier_complete(unsigned* bar, unsigned x, unsigned& nloc, unsigned& nx) {
    const unsigned G = gridDim.x * gridDim.y * gridDim.z;
    unsigned sum, cnt, mine, sp = 0u;
    for (;;) {
        sum = 0u; cnt = 0u; mine = 0u;
#pragma unroll
        for (unsigned j = 0; j < 16; ++j) { const unsigned c = xb_ld(&bar[XB_XCNT(j)]); sum += c; cnt += (c > 0u) ? 1u : 0u; mine = (j == x) ? c : mine; }
        if (sum == G) break;
        __builtin_amdgcn_s_sleep(1);
        if ((++sp & 255u) == 0u) { if (xb_ld(&bar[XB_TMO])) break; if (sp > XB_SPIN_CAP) { atomicAdd(&bar[XB_TMO], 1u); break; } }
    }
    nloc = mine > 0u ? mine : 1u; nx = cnt > 0u ? cnt : 1u;
}
__device__ __forceinline__ void xcd_barrier(const XcdBarrier& b) {
    asm volatile("s_waitcnt vmcnt(0)" ::: "memory");
    __syncthreads();
    if (threadIdx.x == 0) {
        unsigned* bar = b.bar;
        __builtin_amdgcn_s_waitcnt(0);
        unsigned nloc = b.st[0], nx = b.st[1];
        if (nloc == 0u) { xcd_barrier_complete(bar, b.x, nloc, nx); b.st[0] = nloc; b.st[1] = nx; }
        const unsigned old = xb_add(&bar[XB_XSUB(b.x)], 1u);
        const unsigned gen = old / nloc;
        if (old + 1u == (gen + 1u) * nloc) {
            __builtin_amdgcn_fence(__ATOMIC_RELEASE, "agent");
            asm volatile("s_waitcnt vmcnt(0)" ::: "memory");
            const unsigned og = xb_add(&bar[XB_TOP], 1u);
            const unsigned tg = og / nx;
            if (og + 1u == (tg + 1u) * nx) xb_add(&bar[XB_TOPGEN], 1u);
            else XB_SPIN((int)(xb_ld(&bar[XB_TOPGEN]) - (tg + 1u)) < 0, bar);
            __builtin_amdgcn_fence(__ATOMIC_ACQUIRE, "agent");
            xb_add(&bar[XB_XGEN(b.x)], 1u);
            asm volatile("s_waitcnt vmcnt(0)" ::: "memory");
        } else {
            XB_SPIN((int)(xb_ld(&bar[XB_XGEN(b.x)]) - (gen + 1u)) < 0, bar);
            __builtin_amdgcn_fence(__ATOMIC_ACQUIRE, "agent");
            asm volatile("s_waitcnt vmcnt(0)" ::: "memory");
        }
    }
    __syncthreads();
}

__device__ __forceinline__ void xcd_barrier_arrive(const XcdBarrier& b) {
    asm volatile("s_waitcnt vmcnt(0)" ::: "memory");
    __syncthreads();
    if (threadIdx.x == 0) {
        unsigned* bar = b.bar;
        __builtin_amdgcn_s_waitcnt(0);
        unsigned nloc = b.st[0], nx = b.st[1];
        if (nloc == 0u) { xcd_barrier_complete(bar, b.x, nloc, nx); b.st[0] = nloc; b.st[1] = nx; }
        const unsigned old = xb_add(&bar[XB_XSUB(b.x)], 1u);
        const unsigned gen = old / nloc; const bool leader = old + 1u == (gen + 1u) * nloc;
        if (leader) {
            __builtin_amdgcn_fence(__ATOMIC_RELEASE, "agent");
            asm volatile("s_waitcnt vmcnt(0)" ::: "memory");
            const unsigned og = xb_add(&bar[XB_TOP], 1u);
            const unsigned tg = og / nx;
            if (og + 1u == (tg + 1u) * nx) xb_add(&bar[XB_TOPGEN], 1u);
        }
        b.st[2] = gen; b.st[3] = leader ? 1u : 0u;
    }
}
__device__ __forceinline__ void xcd_barrier_wait(const XcdBarrier& b) {
    asm volatile("s_waitcnt vmcnt(0)" ::: "memory");
    __syncthreads();
    if (threadIdx.x == 0) {
        unsigned* bar = b.bar;
        const unsigned gen = b.st[2], leader = b.st[3];
        XB_SPIN((int)(xb_ld(&bar[XB_TOPGEN]) - (gen + 1u)) < 0, bar);
        __builtin_amdgcn_fence(__ATOMIC_ACQUIRE, "agent");
        if (leader) xb_add(&bar[XB_XGEN(b.x)], 1u);
        asm volatile("s_waitcnt vmcnt(0)" ::: "memory");
    }
    __syncthreads();
}

struct Frame {
    LAS unsigned char* lds;
    unsigned char* ws;
    int tid, lane, wave, vcu, G;
};

__device__ __forceinline__ float wave_sum(float v) {
#pragma unroll
    for (int o = 1; o < 64; o <<= 1) v += __shfl_xor(v, o);
    return v;
}

constexpr int TR_SCR_BYTES = 17408;
__device__ __forceinline__ void tr_load(f32x4 (&v)[16], const float* W, int ld, int k0, int n0, int lane) {
    const int l16 = lane & 15, kq = lane >> 4;
#pragma unroll
    for (int i = 0; i < 16; ++i) v[i] = *(const GAS f32x4*)(W + (size_t)(k0 + 4 * i + kq) * ld + n0 + 4 * l16);
}
template <bool FP8> __device__ __forceinline__ void tr_finish(f32x4 (&v)[16], int K, void* WTv, int k0, int drow0, float sc, const float* gk, LAS float* scr, int lane) {
    const int l16 = lane & 15, kq = lane >> 4;
    if (gk) {
#pragma unroll
        for (int i = 0; i < 16; ++i) v[i] = v[i] * gk[k0 + 4 * i + kq]; }
#pragma unroll
    for (int i = 0; i < 16; ++i) { const int k = 4 * i + kq; LAS float* d = scr + k * 65 + (k >> 3) * 4 + 4 * l16; d[0] = v[i][0]; d[1] = v[i][1]; d[2] = v[i][2]; d[3] = v[i][3]; }
    LDS_WAIT(); asm volatile("" ::: "memory");
#define TR_AT(k, n) scr[(k) * 65 + ((k) >> 3) * 4 + (n)]
    if constexpr (FP8) { unsigned char* WT = (unsigned char*)WTv; const int c = lane & 3;
#pragma unroll
        for (int j = 0; j < 4; ++j) { const int n = (lane >> 2) + 16 * j; v4u o;
#pragma unroll
            for (int q = 0; q < 4; ++q) { const int k = 16 * c + 4 * q; o[q] = pk4_fp8(TR_AT(k, n) * sc, TR_AT(k + 1, n) * sc, TR_AT(k + 2, n) * sc, TR_AT(k + 3, n) * sc); }
            *(GAS v4u*)(WT + (size_t)(drow0 + n) * K + k0 + 16 * c) = o; }
    } else { bf16* WT = (bf16*)WTv; const int c = lane & 7;
#pragma unroll
        for (int j = 0; j < 8; ++j) { const int n = (lane >> 3) + 8 * j; v4u o;
#pragma unroll
            for (int q = 0; q < 4; ++q) { const int k = 8 * c + 2 * q; o[q] = cvt_pk_bf16(TR_AT(k, n) * sc, TR_AT(k + 1, n) * sc); }
            *(GAS v4u*)(WT + (size_t)(drow0 + n) * K + k0 + 8 * c) = o; }
    }
#undef TR_AT
    LDS_WAIT(); asm volatile("" ::: "memory");
}
template <bool FP8 = false> __device__ __forceinline__ void transpose_matrix(const float* W, int K, int N, int ld, void* WT, int split, int half, float scale, const float* gk, LAS float* scr, int lane, int gw, int NGW, int& cursor) {
    const int nblk = N / 64, nitems = (K / 64) * nblk;
    int it = (gw - cursor % NGW + NGW) % NGW;
    cursor += nitems;
    if (it >= nitems) return;
    f32x4 v[16], vn[16];
    tr_load(v, W, ld, 64 * (it / nblk), 64 * (it % nblk), lane);
    for (;;) { const int itn = it + NGW; const bool hn = itn < nitems;
        if (hn) tr_load(vn, W, ld, 64 * (itn / nblk), 64 * (itn % nblk), lane);
        const int kb = it / nblk, n0 = 64 * (it % nblk);
        const int drow0 = split == 1 ? ((n0 >> 7) * 256 + half * 128 + (n0 & 127)) : n0;
        const float sc = (split == 2 && (n0 % 3072) < 1024) ? QSCALE * scale : scale;
        tr_finish<FP8>(v, K, WT, 64 * kb, drow0, sc, gk, scr, lane);
        if (!hn) break;
#pragma unroll
        for (int i = 0; i < 16; ++i) v[i] = vn[i];
        it = itn; }
}

__device__ __forceinline__ int t5_bucket(int d) {
    if (d < 16) return d;
    int b = 16;
    b += (d >= 22) + (d >= 30) + (d >= 40) + (d >= 54) + (d >= 73) + (d >= 99) + (d >= 134) + (d >= 182) + (d >= 246) + (d >= 332) + (d >= 450) + (d >= 609) + (d >= 825) + (d >= 1117) + (d >= 1513);
    return b;
}

struct In { const float* p[23]; };
typedef const __attribute__((address_space(4))) unsigned char* kaptr_t;
__device__ __forceinline__ kaptr_t ka_fresh() { kaptr_t p = (kaptr_t)__builtin_amdgcn_kernarg_segment_ptr(); asm volatile("" : "+s"(p)); return p; }
#define INP(k) (*(const float* const __attribute__((address_space(4)))*)(ka_fresh() + 8 * (k)))

template <int PART> __device__ __forceinline__ void p0_prologue(Frame& F) {
    LAS float* scr = (LAS float*)(F.lds + F.wave * TR_SCR_BYTES);
    const int gw = F.vcu * NWAVES + F.wave, NGW = F.G * NWAVES;
    int cur = 0;
    if constexpr (PART == 0) {
    transpose_matrix<true>(INP(1), D, D, D, (void*)(F.ws + W_IN), 0, 0, SWI8, nullptr, scr, F.lane, gw, NGW, cur);
    } else {
    transpose_matrix<true>(INP(10), D, D, 2 * D, (void*)(F.ws + W_GLU), 1, 0, SWG8, nullptr, scr, F.lane, gw, NGW, cur);
    transpose_matrix<true>(INP(10) + D, D, D, 2 * D, (void*)(F.ws + W_GLU), 1, 1, SWG8, nullptr, scr, F.lane, gw, NGW, cur);
    }
    if constexpr (PART == 0) {
    { const float* x = INP(0); unsigned char* xq = (unsigned char*)(F.ws + WS_XB0); const size_t n16 = (size_t)M * D / 16; const size_t gt = (size_t)gw * 64 + F.lane, NT = (size_t)NGW * 64;
      for (size_t i0 = gt; i0 < n16; i0 += 4 * NT) {
          f32x4 v[4][4];
#pragma unroll
          for (int t = 0; t < 4; ++t) { const size_t i = i0 + t * NT; if (i < n16) {
#pragma unroll
              for (int q = 0; q < 4; ++q) v[t][q] = *(const GAS f32x4*)(x + i * 16 + 4 * q); } }
#pragma unroll
          for (int t = 0; t < 4; ++t) { const size_t i = i0 + t * NT; if (i < n16) { v4u o;
#pragma unroll
              for (int q = 0; q < 4; ++q) { const f32x4 a = v[t][q] * SX8; o[q] = pk4_fp8(a[0], a[1], a[2], a[3]); }
              *(GAS v4u*)(xq + i * 16) = o; } } } }
    return; }
    const int gt = gw * 64 + F.lane, NT = NGW * 64;
    const float* a_re = INP(2); const float* a_im = INP(3); const float* log_dt = INP(4); const float* b_re = INP(5); const float* b_im = INP(6);
    const float* c_re = INP(7); const float* c_im = INP(8); const float* dsk = INP(9);
    for (int i = gt; i < 64 * 4 * 64; i += NT) { const int l = i & 63, j = (i >> 6) & 3, g = i >> 8; const int p = (l & 31) + 32 * (j >> 1);
        const double dt = exp((double)log_dt[g]); const double lr = fmin((double)a_re[g * 64 + p], -1e-4), li = (double)a_im[g * 64 + p];
        const double mag = exp(lr * dt), abr = mag * cos(li * dt), abi = mag * sin(li * dt), den = lr * lr + li * li, nr = abr - 1.0;
        const double qr = (nr * lr + abi * li) / den, qi = (abi * lr - nr * li) / den;
        float v[8];
#pragma unroll
        for (int e = 0; e < 8; ++e) { const int c = 8 * (l >> 5) + e; const double br = b_re[(g * 64 + p) * 16 + c], bi = b_im[(g * 64 + p) * 16 + c];
            v[e] = (float)((j & 1) ? (qr * bi + qi * br) : (qr * br - qi * bi)); }
        v4u o; o.x = cvt_pk_bf16(v[0], v[1]); o.y = cvt_pk_bf16(v[2], v[3]); o.z = cvt_pk_bf16(v[4], v[5]); o.w = cvt_pk_bf16(v[6], v[7]);
        *(GAS v4u*)(F.ws + WS_TAB + TAB_BB + (size_t)i * 16) = o; }
    for (int i = gt; i < 64 * 5 * 64; i += NT) { const int l = i & 63, ks = (i >> 6) % 5, g = i / 320; const int c = l & 15;
        float v[8];
#pragma unroll
        for (int e = 0; e < 8; ++e) { const int kk = 8 * (l >> 4) + e;
            if (ks < 4) { const int k2 = 32 * ks + kk, n = k2 >> 2, q = k2 & 3, p = n + 32 * (q >> 1); v[e] = (q & 1) ? -c_im[(g * 16 + c) * 64 + p] : c_re[(g * 16 + c) * 64 + p]; }
            else v[e] = (kk == c) ? dsk[g * 16 + c] : 0.f; }
        v4u o; o.x = cvt_pk_bf16(v[0], v[1]); o.y = cvt_pk_bf16(v[2], v[3]); o.z = cvt_pk_bf16(v[4], v[5]); o.w = cvt_pk_bf16(v[6], v[7]);
        *(GAS v4u*)(F.ws + WS_TAB + TAB_CC + (size_t)i * 16) = o; }
    for (int i = gt; i < 64 * 32 * 4; i += NT) { const int pw = i & 3, n = (i >> 2) & 31, g = i >> 7; const double kpow = pw == 0 ? 1.0 : pw == 1 ? 16.0 : pw == 2 ? 32.0 : 1024.0;
        const double dt = exp((double)log_dt[g]); f32x4 o;
#pragma unroll
        for (int s = 0; s < 2; ++s) { const int p = n + 32 * s; const double lr = fmin((double)a_re[g * 64 + p], -1e-4), li = (double)a_im[g * 64 + p];
            const double mag = exp(kpow * lr * dt); o[2 * s] = (float)(mag * cos(kpow * li * dt)); o[2 * s + 1] = (float)(mag * sin(kpow * li * dt)); }
        *(GAS f32x4*)(F.ws + WS_TAB + TAB_AB + (size_t)i * 16) = o; }
    { const float* relb = INP(13);
      for (int i = gt; i < 3 * 16 * 256; i += NT) { const int y = i & 255, h = (i >> 8) & 15, g = i >> 12; const int dil = g == 0 ? 1 : g == 1 ? 4 : 16; const int off = 191 - y;
          const float v = (off >= 0 && off <= 128) ? relb[t5_bucket(off * dil) * 16 + h] * LOG2E : -1e30f;
          *(GAS float*)(F.ws + WS_TAB + TAB_BIAS + (size_t)i * 4) = v; } }
}

template <bool FP8> __device__ __forceinline__ void colvec_pass(Frame& F, const void* Wt, int nrows, float inv_scale, const float* gam, const float* bet, float* cv, float* dv) {
    const int gw = F.vcu * NWAVES + F.wave, NGW = F.G * NWAVES;
    float ratio[16];
#pragma unroll
    for (int j = 0; j < 16; ++j) ratio[j] = bet[F.lane * 16 + j] / gam[F.lane * 16 + j];
    for (int n = gw; n < nrows; n += NGW) { float w[16];
        if constexpr (FP8) { const v4u q = *(const GAS v4u*)((const unsigned char*)Wt + (size_t)n * D + F.lane * 16);
#pragma unroll
            for (int j = 0; j < 4; ++j) { w[4 * j] = __builtin_amdgcn_cvt_f32_fp8((int)q[j], 0); w[4 * j + 1] = __builtin_amdgcn_cvt_f32_fp8((int)q[j], 1); w[4 * j + 2] = __builtin_amdgcn_cvt_f32_fp8((int)q[j], 2); w[4 * j + 3] = __builtin_amdgcn_cvt_f32_fp8((int)q[j], 3); }
        } else { const v4u q0 = *(const GAS v4u*)((const bf16*)Wt + (size_t)n * D + F.lane * 16), q1 = *(const GAS v4u*)((const bf16*)Wt + (size_t)n * D + F.lane * 16 + 8);
#pragma unroll
            for (int j = 0; j < 4; ++j) { w[2 * j] = bf_lo(q0[j]); w[2 * j + 1] = bf_hi(q0[j]); w[8 + 2 * j] = bf_lo(q1[j]); w[8 + 2 * j + 1] = bf_hi(q1[j]); } }
        float c = 0.f, d = 0.f;
#pragma unroll
        for (int j = 0; j < 16; ++j) { c += w[j]; d += w[j] * ratio[j]; }
        c = wave_sum(c) * inv_scale; d = wave_sum(d) * inv_scale;
        if (F.lane == 0) { cv[n] = c; dv[n] = d; } }
}

__device__ __forceinline__ float gelu_tanh(float x) { const float z = 1.5957691216057308f * (x + 0.044715f * x * x * x); return x * pg8::sigmoidf_fast(z); }
#define CMUL_ADD(or_, oi_, ar_, ai_, hr_, hi_, br_, bi_) do { float _p = fmaf((ar_), (hr_), (br_)); asm("" : "+v"(_p)); float _q = fmaf((ar_), (hi_), (bi_)); const float _t = fmaf(-(ai_), (hi_), _p); asm("" : "+v"(_q)); const float _u = fmaf((ai_), (hr_), _q); or_ = _t; oi_ = _u; } while (0)

template <bool OUT> __device__ __forceinline__ void s5_phase(Frame& F) {
    const int lane = F.lane, n = lane & 31, hh = lane >> 5;
    LAS unsigned char* ldsw = F.lds + F.wave * 8704;
    const int gw = F.vcu * NWAVES + F.wave, NGW = F.G * NWAVES;
    const bf16* U = (const bf16*)(F.ws + WS_U); bf16* Yb = (bf16*)(F.ws + WS_YB); float* E = (float*)(F.ws + WS_E);
    const int tokA = ((n >> 2) & 1) * 16 + (n >> 3) * 4 + (n & 3);
    for (int unit = gw; unit < 2048; unit += NGW) {
        const int bg = unit >> 4, c = unit & 15, b = bg >> 6, g = bg & 63;
        const bf16* up = U + ((size_t)bg * 16384 + (size_t)c * 1024) * 16;
        bf16x8 BBf[4];
#pragma unroll
        for (int j = 0; j < 4; ++j) BBf[j] = *(const GAS bf16x8*)(F.ws + WS_TAB + TAB_BB + ((size_t)(g * 4 + j) * 64 + lane) * 16);
        const f32x4 a1 = *(const GAS f32x4*)(F.ws + WS_TAB + TAB_AB + ((size_t)(g * 32 + n) * 4 + 0) * 16);
        const f32x4 a16 = *(const GAS f32x4*)(F.ws + WS_TAB + TAB_AB + ((size_t)(g * 32 + n) * 4 + 1) * 16);
        const f32x4 a32 = *(const GAS f32x4*)(F.ws + WS_TAB + TAB_AB + ((size_t)(g * 32 + n) * 4 + 2) * 16);
        bf16x8 CCf[5];
        float s0r = 0.f, s0i = 0.f, s1r = 0.f, s1i = 0.f;
        if constexpr (OUT) {
#pragma unroll
            for (int ks = 0; ks < 5; ++ks) CCf[ks] = *(const GAS bf16x8*)(F.ws + WS_TAB + TAB_CC + ((size_t)(g * 5 + ks) * 64 + lane) * 16);
            const f32x4 ak = *(const GAS f32x4*)(F.ws + WS_TAB + TAB_AB + ((size_t)(g * 32 + n) * 4 + 3) * 16);
            f32x4 ev[15];
#pragma unroll
            for (int cp = 0; cp < 15; ++cp) { ev[cp] = (f32x4){0.f, 0.f, 0.f, 0.f}; if (cp < c) ev[cp] = *(const GAS f32x4*)(E + ((size_t)(bg * 16 + cp) * 128 + 4 * n)); }
#pragma unroll
            for (int cp = 0; cp < 15; ++cp) if (cp < c) { CMUL_ADD(s0r, s0i, ak[0], ak[1], s0r, s0i, ev[cp][0], ev[cp][1]); CMUL_ADD(s1r, s1i, ak[2], ak[3], s1r, s1i, ev[cp][2], ev[cp][3]); }
        }
        bf16x8 Af = *(const GAS bf16x8*)(up + (size_t)tokA * 16 + 8 * hh);
        const int tq_ = lane >> 4, tl_ = lane & 15;
        bf16x8 Bun[2] = {{0, 0, 0, 0, 0, 0, 0, 0}, {0, 0, 0, 0, 0, 0, 0, 0}};
        if constexpr (OUT) { if (tq_ < 2) { Bun[0] = *(const GAS bf16x8*)(up + (size_t)tl_ * 16 + 8 * tq_); Bun[1] = *(const GAS bf16x8*)(up + (size_t)(16 + tl_) * 16 + 8 * tq_); } }
#pragma unroll 2
        for (int tile = 0; tile < 32; ++tile) {
            const bf16x8 Ac = Af; const bf16x8 Bu0 = Bun[0], Bu1 = Bun[1];
            if (tile + 1 < 32) { Af = *(const GAS bf16x8*)(up + (size_t)((tile + 1) * 32 + tokA) * 16 + 8 * hh);
                if constexpr (OUT) { if (tq_ < 2) { Bun[0] = *(const GAS bf16x8*)(up + (size_t)((tile + 1) * 32 + tl_) * 16 + 8 * tq_); Bun[1] = *(const GAS bf16x8*)(up + (size_t)((tile + 1) * 32 + 16 + tl_) * 16 + 8 * tq_); } } }
            f32x16 bu[4];
#pragma unroll
            for (int j = 0; j < 4; ++j) { const f32x16 z = {}; bu[j] = __builtin_amdgcn_mfma_f32_32x32x16_bf16(Ac, BBf[j], z, 0, 0, 0); }
            float e0r = 0.f, e0i = 0.f, e1r = 0.f, e1i = 0.f;
#pragma unroll
            for (int r = 0; r < 16; ++r) { CMUL_ADD(e0r, e0i, a1[0], a1[1], e0r, e0i, bu[0][r], bu[1][r]); CMUL_ADD(e1r, e1i, a1[2], a1[3], e1r, e1i, bu[2][r], bu[3][r]); }
            float lo0r, lo0i, lo1r, lo1i, hi0r, hi0i, hi1r, hi1i;
            { const float o = __shfl_xor(e0r, 32); lo0r = hh ? o : e0r; hi0r = hh ? e0r : o; }
            { const float o = __shfl_xor(e0i, 32); lo0i = hh ? o : e0i; hi0i = hh ? e0i : o; }
            { const float o = __shfl_xor(e1r, 32); lo1r = hh ? o : e1r; hi1r = hh ? e1r : o; }
            { const float o = __shfl_xor(e1i, 32); lo1i = hh ? o : e1i; hi1i = hh ? e1i : o; }
            float m0r, m0i, m1r, m1i;
            CMUL_ADD(m0r, m0i, a16[0], a16[1], s0r, s0i, lo0r, lo0i); CMUL_ADD(m1r, m1i, a16[2], a16[3], s1r, s1i, lo1r, lo1i);
            if constexpr (OUT) {
                float h0r = hh ? m0r : s0r, h0i = hh ? m0i : s0i, h1r = hh ? m1r : s1r, h1i = hh ? m1i : s1i;
#pragma unroll
                for (int r = 0; r < 16; ++r) { CMUL_ADD(h0r, h0i, a1[0], a1[1], h0r, h0i, bu[0][r], bu[1][r]); CMUL_ADD(h1r, h1i, a1[2], a1[3], h1r, h1i, bu[2][r], bu[3][r]);
                    v2u w; w.x = cvt_pk_bf16(h0r, h0i); w.y = cvt_pk_bf16(h1r, h1i);
                    *(LAS v2u*)(ldsw + (16 * hh + r) * 272 + 8 * n) = w; }
            }
            asm volatile("" ::: "memory");
            CMUL_ADD(s0r, s0i, a16[0], a16[1], m0r, m0i, hi0r, hi0i); CMUL_ADD(s1r, s1i, a16[2], a16[3], m1r, m1i, hi1r, hi1i);
            if constexpr (OUT) {
                const int tq = lane >> 4, tl = lane & 15;
#pragma unroll
                for (int nt = 0; nt < 2; ++nt) {
                    pg8::f32x4 acc = {0.f, 0.f, 0.f, 0.f};
#pragma unroll
                    for (int ks = 0; ks < 4; ++ks) { const bf16x8 Bf = *(const LAS bf16x8*)(ldsw + (16 * nt + tl) * 272 + (32 * ks + 8 * tq) * 2);
                        acc = __builtin_amdgcn_mfma_f32_16x16x32_bf16(CCf[ks], Bf, acc, 0, 0, 0); }
                    acc = __builtin_amdgcn_mfma_f32_16x16x32_bf16(CCf[4], nt == 0 ? Bu0 : Bu1, acc, 0, 0, 0);
                    *(GAS unsigned*)((unsigned char*)Yb + ((size_t)(b * SEQ + c * 1024 + tile * 32 + 16 * nt + tl)) * D + g * 16 + 4 * tq) = pk4_fp8(gelu_tanh(acc[0]) * SY8, gelu_tanh(acc[1]) * SY8, gelu_tanh(acc[2]) * SY8, gelu_tanh(acc[3]) * SY8);
                }
                asm volatile("" ::: "memory");
            }
        }
        if constexpr (!OUT) { if (hh == 0) { f32x4 o = {s0r, s0i, s1r, s1i}; *(GAS f32x4*)(E + ((size_t)(bg * 16 + c) * 128 + 4 * n)) = o; } }
    }
}

__device__ __forceinline__ void ln_stats(const f32x4 (&v)[4], float& mean, float& rstd) {
    float s = 0.f;
#pragma unroll
    for (int j = 0; j < 4; ++j) s += (v[j][0] + v[j][1]) + (v[j][2] + v[j][3]);
    mean = wave_sum(s) * (1.f / D); float s2 = 0.f;
#pragma unroll
    for (int j = 0; j < 4; ++j) { const f32x4 d = v[j] - mean; s2 += (d[0] * d[0] + d[1] * d[1]) + (d[2] * d[2] + d[3] * d[3]); }
    rstd = 1.0f / sqrtf(wave_sum(s2) * (1.f / D) + LN_EPS);
}
template <bool Q8> __device__ __forceinline__ void ln_pass(Frame& F, const bf16* Z, const float* gam, const float* bet, bf16* xb, unsigned char* xq) {
    const int gw = F.vcu * NWAVES + F.wave, NGW = F.G * NWAVES;
    f32x4 gv[4], bv[4];
#pragma unroll
    for (int j = 0; j < 4; ++j) { gv[j] = *(const GAS f32x4*)(gam + F.lane * 4 + 256 * j); bv[j] = *(const GAS f32x4*)(bet + F.lane * 4 + 256 * j); }
    for (int row = gw; row < M; row += NGW) {
        f32x4 v[4];
#pragma unroll
        for (int j = 0; j < 4; ++j) { const v2u zw = *(const GAS v2u*)(Z + (size_t)row * D + F.lane * 4 + 256 * j); v[j] = (f32x4){bf_lo(zw.x), bf_hi(zw.x), bf_lo(zw.y), bf_hi(zw.y)}; }
        float mean, rstd; ln_stats(v, mean, rstd);
#pragma unroll
        for (int j = 0; j < 4; ++j) { const f32x4 y = (v[j] - mean) * rstd * gv[j] + bv[j]; v2u w; w.x = cvt_pk_bf16(y[0], y[1]); w.y = cvt_pk_bf16(y[2], y[3]);
            *(GAS v2u*)(xb + (size_t)row * D + F.lane * 4 + 256 * j) = w;
            if constexpr (Q8) *(GAS unsigned*)(xq + (size_t)row * D + F.lane * 4 + 256 * j) = pk4_fp8(y[0] * SX8, y[1] * SX8, y[2] * SX8, y[3] * SX8); }
    }
}
__device__ __forceinline__ void ln_router_pass(Frame& F, const bf16* Z, const float* gam, const float* bet, const float* wr, bf16* xb, unsigned char* xq) {
    f32x4 gv[4], bv[4];
#pragma unroll
    for (int j = 0; j < 4; ++j) { gv[j] = *(const GAS f32x4*)(gam + F.lane * 4 + 256 * j); bv[j] = *(const GAS f32x4*)(bet + F.lane * 4 + 256 * j); }
    f32x4 w0[4][4], w1[4][4];
#pragma unroll
    for (int j = 0; j < 4; ++j)
#pragma unroll
        for (int i = 0; i < 4; ++i) { const int k = F.lane * 4 + 256 * j + i; w0[j][i] = *(const GAS f32x4*)(wr + (size_t)k * 8); w1[j][i] = *(const GAS f32x4*)(wr + (size_t)k * 8 + 4); }
    volatile LAS unsigned* lcnt = (volatile LAS unsigned*)(F.lds + LDSCTL_OFF + 64);
    volatile LAS unsigned* lbase = (volatile LAS unsigned*)(F.lds + LDSCTL_OFF + 96);
    LAS unsigned* rinfo = (LAS unsigned*)(F.lds);
    if (F.tid < 8) lcnt[F.tid] = 0u;
    __syncthreads();
    int* slot_tok = (int*)(F.ws + WS_ROUTE + ROUTE_ST);
    for (int i = blockIdx.x * NTHREADS + F.tid; i < MAXSLOT; i += F.G * NTHREADS) slot_tok[i] = -1;
    const int rowb = blockIdx.x * 128;
    v2u zn[4];
#pragma unroll
    for (int j = 0; j < 4; ++j) zn[j] = *(const GAS v2u*)(Z + (size_t)(rowb + F.wave * 16) * D + F.lane * 4 + 256 * j);
    for (int k = 0; k < 16; ++k) {
        const int rl = F.wave * 16 + k, row = rowb + rl;
        f32x4 v[4];
#pragma unroll
        for (int j = 0; j < 4; ++j) v[j] = (f32x4){bf_lo(zn[j].x), bf_hi(zn[j].x), bf_lo(zn[j].y), bf_hi(zn[j].y)};
        if (k + 1 < 16) {
#pragma unroll
            for (int j = 0; j < 4; ++j) zn[j] = *(const GAS v2u*)(Z + (size_t)(row + 1) * D + F.lane * 4 + 256 * j); }
        float mean, rstd; ln_stats(v, mean, rstd);
        f32x4 la = {0.f, 0.f, 0.f, 0.f}, lb = {0.f, 0.f, 0.f, 0.f};
#pragma unroll
        for (int j = 0; j < 4; ++j) { const f32x4 y = (v[j] - mean) * rstd * gv[j] + bv[j]; v2u w; w.x = cvt_pk_bf16(y[0], y[1]); w.y = cvt_pk_bf16(y[2], y[3]);
            *(GAS v2u*)(xb + (size_t)row * D + F.lane * 4 + 256 * j) = w;
            *(GAS unsigned*)(xq + (size_t)row * D + F.lane * 4 + 256 * j) = pk4_fp8(y[0] * SX8, y[1] * SX8, y[2] * SX8, y[3] * SX8);
#pragma unroll
            for (int i = 0; i < 4; ++i) { la += w0[j][i] * y[i]; lb += w1[j][i] * y[i]; } }
        float lg[8];
#pragma unroll
        for (int e = 0; e < 4; ++e) { lg[e] = wave_sum(la[e]); lg[4 + e] = wave_sum(lb[e]); }
        int e1 = 0; float v1 = lg[0];
#pragma unroll
        for (int e = 1; e < 8; ++e) if (lg[e] > v1) { v1 = lg[e]; e1 = e; }
        int e2 = -1; float v2 = -INFINITY;
#pragma unroll
        for (int e = 0; e < 8; ++e) if (e != e1 && lg[e] > v2) { v2 = lg[e]; e2 = e; }
        const float t = __expf(v2 - v1), g1 = 1.0f / (1.0f + t), g2 = t * g1;
        if (F.lane == 0) {
            const unsigned l1 = __hip_atomic_fetch_add((LAS unsigned*)&lcnt[e1], 1u, __ATOMIC_RELAXED, __HIP_MEMORY_SCOPE_WORKGROUP);
            const unsigned l2 = __hip_atomic_fetch_add((LAS unsigned*)&lcnt[e2], 1u, __ATOMIC_RELAXED, __HIP_MEMORY_SCOPE_WORKGROUP);
            rinfo[rl * 8 + 0] = (unsigned)e1; rinfo[rl * 8 + 1] = (unsigned)e2; rinfo[rl * 8 + 2] = l1; rinfo[rl * 8 + 3] = l2;
            rinfo[rl * 8 + 4] = __float_as_uint(g1); rinfo[rl * 8 + 5] = __float_as_uint(g2);
        }
    }
    __syncthreads();
    if (F.tid < 8) lbase[F.tid] = __hip_atomic_fetch_add((unsigned*)(F.ws + WS_CTL) + CW_CNT + F.tid, lcnt[F.tid], RLX_AGENT);
    __syncthreads();
    if (F.tid < 128) { const int rl = F.tid; const unsigned e1 = rinfo[rl * 8], e2 = rinfo[rl * 8 + 1];
        int4 ri; ri.x = (int)e1; ri.y = (int)e2; ri.z = (int)(lbase[e1] + rinfo[rl * 8 + 2]); ri.w = (int)(lbase[e2] + rinfo[rl * 8 + 3]);
        *(int4*)(F.ws + WS_ROUTE + ROUTE_I + (size_t)(rowb + rl) * 16) = ri;
        float2 rg; rg.x = __uint_as_float(rinfo[rl * 8 + 4]); rg.y = __uint_as_float(rinfo[rl * 8 + 5]);
        *(float2*)(F.ws + WS_ROUTE + ROUTE_G + (size_t)(rowb + rl) * 8) = rg; }
    __syncthreads();
}

__device__ __forceinline__ void moe_tiles(const Frame& F, int (&tp)[9]) {
    const unsigned* cnt = (const unsigned*)(F.ws + WS_CTL) + CW_CNT;
    int acc = 0;
#pragma unroll
    for (int e = 0; e < 8; ++e) { tp[e] = acc; const int c = (int)__builtin_amdgcn_readfirstlane(__hip_atomic_load(cnt + e, RLX_AGENT)); acc += (c + 255) >> 8; }
    tp[8] = acc;
}

namespace att {
constexpr int LDS_V = 0, LDS_K = 49152, LDS_BIAS = 98304, LDS_WS = 99328, LDS_OST = 101376, LDS_END = 134144;
static_assert(LDS_END <= RING_BYTES, "attention LDS");
__device__ __forceinline__ int crow(int r, int hi) { return (r & 3) + 8 * (r >> 2) + 4 * hi; }
__device__ __forceinline__ s16x4 vtr(const LAS unsigned char* p) { typedef short v4i16_t __attribute__((ext_vector_type(4))); return __builtin_bit_cast(s16x4, __builtin_amdgcn_ds_read_tr16_b64_v4i16((LAS v4i16_t*)p)); }
__device__ __forceinline__ v2u vtr8(const LAS unsigned char* p) { typedef int v2i32_t __attribute__((ext_vector_type(2))); return __builtin_bit_cast(v2u, __builtin_amdgcn_ds_read_tr8_b64_v2i32((LAS v2i32_t*)p)); }
__device__ __forceinline__ int mod6(int x) { return x >= 6 ? x - 6 : x; }

struct UnitDesc { int r, n2, ub, first; };
__device__ __forceinline__ void glds16(const void* gsrc, unsigned lds_dst) { unsigned keep;
    asm volatile("s_mov_b32 %0, m0\n\ts_mov_b32 m0, %2\n\ts_nop 0\n\tglobal_load_lds_dwordx4 %1, off\n\ts_mov_b32 m0, %0" : "=&s"(keep) : "v"(gsrc), "s"(lds_dst) : "memory"); }
__device__ __forceinline__ unsigned lds_addr(const LAS unsigned char* p) { return (unsigned)__builtin_amdgcn_readfirstlane((int)(unsigned)(uintptr_t)p); }
__device__ __forceinline__ void issue_q(const Frame& F, int dil, int b, int h, const UnitDesc& u, const bf16* Q, v4u (&qw)[2]) {
    const int r32 = F.lane & 31, hi = F.lane >> 5; const size_t qrow = (size_t)(b * 16 + h) * SEQ + (size_t)u.r * (SEQ / dil) + (256 * u.n2 + 32 * F.wave + r32);
#pragma unroll
    for (int j = 0; j < 2; ++j) qw[j] = *(const GAS v4u*)((const unsigned char*)Q + qrow * 64 + hi * 32 + j * 16);
}
__device__ __forceinline__ void issue_k(const Frame& F, int dil, int b, int h, const UnitDesc& u, const bf16* K) {
    const int lane = F.lane, wid = F.wave; const int KB = 256 * u.n2 - 128; const int kl = 16 * (wid & 3) + (lane >> 2);
#pragma unroll
    for (int t = 0; t < 6; ++t) { if (t >= u.first && (t & 1) == (wid >> 2)) {
        int ik = KB + 64 * t + kl; ik = ik < 0 ? 0 : ik;
        const unsigned char* ksrc = (const unsigned char*)K + ((size_t)(b * 16 + h) * SEQ + (size_t)u.r * (SEQ / dil) + ik) * 64 + (lane & 3) * 16;
        glds16(ksrc, lds_addr(F.lds + LDS_K + mod6(u.ub + t) * 8192 + (wid & 3) * 1024)); } }
}
__device__ __forceinline__ void issue_v(const Frame& F, int dil, int b, int h, const UnitDesc& u, const bf16* V) {
    const int lane = F.lane, wid = F.wave; const int KB = 256 * u.n2 - 128;
#pragma unroll
    for (int t = 0; t < 6; ++t) { if (t >= u.first && (t & 1) == (wid >> 2)) {
        int iv = KB + 64 * t + 16 * (wid & 3) + (lane >> 2); iv = iv < 0 ? 0 : iv;
        const unsigned char* vsrc = (const unsigned char*)V + ((size_t)(b * 16 + h) * SEQ + (size_t)u.r * (SEQ / dil) + iv) * 64 + (lane & 3) * 16;
        glds16(vsrc, lds_addr(F.lds + LDS_V + mod6(u.ub + t) * 8192 + (wid & 3) * 1024)); } }
}

template <bool MERGE>
__device__ __forceinline__ void attn_phase(Frame& F, int gi, const bf16* Q, const bf16* K, const bf16* V, bf16* O, float* lse_out, const bf16* O0, const bf16* O1, const float* L0, const float* L1) {
    const int dil = gi == 0 ? 1 : gi == 1 ? 4 : 16, nb2 = 64 / dil;
    const int bh = F.vcu >> 3, s = F.vcu & 7, b = bh >> 4, h = bh & 15;
    const int lane = F.lane, r32 = lane & 31, hi = lane >> 5, wid = F.wave;
    LAS unsigned char* lds = F.lds;
    const size_t rowbase = (size_t)b * SEQ;
    { const float* T = (const float*)(F.ws + WS_TAB + TAB_BIAS) + (size_t)(gi * 16 + h) * 256; if (F.tid < 256) ((LAS float*)(lds + LDS_BIAS))[F.tid] = T[F.tid]; }
    __syncthreads();
    const int T0 = wid >> 1;
    const LAS unsigned char* bl = lds + LDS_BIAS + 4 * (63 - 32 * (wid & 1) - r32 + 4 * hi);
    const int vlane = (4 * hi + (((lane & 15) >> 1) & 3) + 8 * ((lane & 15) >> 3)) * 64 + ((lane >> 4) & 1) * 16 + (lane & 1) * 8;
    LAS float* wsf = (LAS float*)(lds + LDS_WS) + wid * 64;
    LAS bf16* stg = (LAS bf16*)(lds + LDS_OST) + wid * 2048;
    UnitDesc u; { const int idx = s * 8; u.n2 = idx % nb2; u.r = idx / nb2; u.ub = 0; u.first = 0; }
    v4u qw[2];
    issue_q(F, dil, b, h, u, Q, qw); issue_k(F, dil, b, h, u, K);
#pragma unroll 1
    for (int i = 0; i < 8; ++i) {
        const int n2 = u.n2, r = u.r; const int I0 = 256 * n2;
        if (i == 0) asm volatile("s_waitcnt vmcnt(0)" ::: "memory"); else asm volatile("s_waitcnt vmcnt(4)" ::: "memory");
        __builtin_amdgcn_s_barrier();
        asm volatile("" ::: "memory");
        int sl[3];
#pragma unroll
        for (int j = 0; j < 3; ++j) sl[j] = mod6(u.ub + T0 + j) * 8192;
        f32x16 S[6];
#pragma unroll
        for (int tt = 0; tt < 6; ++tt) {
            if ((tt == 0 && (wid & 1)) || (tt == 5 && !(wid & 1))) {
#pragma unroll
                for (int rr = 0; rr < 16; ++rr) S[tt][rr] = 0.f;
                continue; }
#pragma unroll
            for (int rr = 0; rr < 16; ++rr) S[tt][rr] = *(const LAS float*)(bl + 4 * (32 * tt + (rr & 3) + 8 * (rr >> 2)));
            if (n2 == 0 && 2 * T0 + tt < 4) {
#pragma unroll
                for (int rr = 0; rr < 16; ++rr) S[tt][rr] = -1e30f; }
            const int kk_ = (tt & 1) * 32 + r32; const LAS unsigned char* kp = lds + LDS_K + sl[tt >> 1] + kk_ * 64; const int ksw = (kk_ >> 2) & 3;
            { const v4u kf0 = *(const LAS v4u*)(kp + (((2 * hi) ^ ksw) << 4)), kf1 = *(const LAS v4u*)(kp + (((2 * hi + 1) ^ ksw) << 4));
              typedef int i32x8_t __attribute__((ext_vector_type(8)));
              const i32x8_t ka = __builtin_bit_cast(i32x8_t, __builtin_shufflevector(kf0, kf1, 0, 1, 2, 3, 4, 5, 6, 7)), qb = __builtin_bit_cast(i32x8_t, __builtin_shufflevector(qw[0], qw[1], 0, 1, 2, 3, 4, 5, 6, 7));
              asm volatile("v_mfma_f32_32x32x64_f8f6f4 %0, %1, %2, %0" : "+v"(S[tt]) : "v"(ka), "v"(qb)); }
            if (tt == 1) issue_v(F, dil, b, h, u, V);
        }
        asm volatile("s_nop 15\n\ts_nop 15\n\ts_nop 15\n\ts_nop 15\n\ts_nop 15" ::: "memory");
        __builtin_amdgcn_s_barrier();
        asm volatile("" ::: "memory");
        UnitDesc nu = u;
        if (i + 1 < 8) { const int idx = s * 8 + i + 1; nu.n2 = idx % nb2; nu.r = idx / nb2; const bool cont = (nu.r == r) && (nu.n2 == n2 + 1);
            nu.ub = cont ? mod6(u.ub + 4) : 0; nu.first = cont ? 2 : 0;
            issue_q(F, dil, b, h, nu, Q, qw); issue_k(F, dil, b, h, nu, K); }
        float mx = S[1][0];
#pragma unroll
        for (int tt = 0; tt < 6; ++tt) {
            if ((tt == 0 && (wid & 1)) || (tt == 5 && !(wid & 1))) continue;
#pragma unroll
            for (int rr = 0; rr < 16; ++rr) mx = fmaxf(mx, S[tt][rr]); }
        { auto rr = __builtin_amdgcn_permlane32_swap(__float_as_uint(mx), __float_as_uint(mx), false, false); mx = fmaxf(__uint_as_float(rr[0]), __uint_as_float(rr[1])); }
        const float mxm8 = mx - 8.f;
        float lsum = 0.f;
#pragma unroll
        for (int tt = 0; tt < 6; ++tt) {
            if ((tt == 0 && (wid & 1)) || (tt == 5 && !(wid & 1))) continue;
#pragma unroll
            for (int rr = 0; rr < 16; ++rr) { const float p = __builtin_amdgcn_exp2f(S[tt][rr] - mxm8); S[tt][rr] = p; lsum += p; } }
        { auto rr = __builtin_amdgcn_permlane32_swap(__float_as_uint(lsum), __float_as_uint(lsum), false, false); lsum = __uint_as_float(rr[0]) + __uint_as_float(rr[1]); }
        if (i + 1 >= 8) asm volatile("s_waitcnt vmcnt(0)" ::: "memory"); else if (nu.first == 0) asm volatile("s_waitcnt vmcnt(5)" ::: "memory"); else asm volatile("s_waitcnt vmcnt(4)" ::: "memory");
        __builtin_amdgcn_s_barrier();
        asm volatile("" ::: "memory");
        v2u ma[4], mc[4]; float ml0[4], ml1[4];
        if constexpr (MERGE) {
#pragma unroll
            for (int j = 0; j < 4; ++j) { const int row = j * 8 + (lane >> 3); const int tq = (I0 + 32 * wid + row) * dil + r;
                const size_t idh = (size_t)(b * 16 + h) * SEQ + (size_t)(tq & 15) * (SEQ / 16) + (tq >> 4);
                ml0[j] = L0[idh]; ml1[j] = L1[idh]; } }
        f32x16 o[2]; o[0] = f32x16{}; o[1] = f32x16{}; asm volatile("" : "+v"(o[0]), "+v"(o[1]));
#pragma unroll
        for (int pp = 0; pp < 3; ++pp) {
            typedef int i32x8_t __attribute__((ext_vector_type(8)));
            i32x8_t pa;
#pragma unroll
            for (int e = 0; e < 8; ++e) { const int tt = 2 * pp + (e >> 2), j = 4 * (e & 3);
                int w8 = __builtin_amdgcn_cvt_pk_fp8_f32(S[tt][j], S[tt][j + 1], 0, false); w8 = __builtin_amdgcn_cvt_pk_fp8_f32(S[tt][j + 2], S[tt][j + 3], w8, true); pa[e] = w8; }
            const LAS unsigned char* vp = lds + LDS_V + sl[pp] + vlane;
#pragma unroll
            for (int d0 = 0; d0 < 2; ++d0) { const v2u v0 = vtr8(vp + d0 * 32), v1 = vtr8(vp + d0 * 32 + 1024), v2 = vtr8(vp + d0 * 32 + 2048), v3 = vtr8(vp + d0 * 32 + 3072);
                const i32x8_t vb = {(int)v0.x, (int)v0.y, (int)v1.x, (int)v1.y, (int)v2.x, (int)v2.y, (int)v3.x, (int)v3.y};
                asm volatile("s_nop 4\n\tv_mfma_f32_32x32x64_f8f6f4 %0, %1, %2, %0" : "+v"(o[d0]) : "v"(pa), "v"(vb)); }
        }
        asm volatile("s_nop 15\n\ts_nop 15\n\ts_nop 15\n\ts_nop 15\n\ts_nop 15" ::: "memory");
        if constexpr (MERGE) {
#pragma unroll
            for (int j = 0; j < 4; ++j) { const int row = j * 8 + (lane >> 3), ch = lane & 7; const int tq = (I0 + 32 * wid + row) * dil + r;
                const size_t offh = ((size_t)(b * 16 + h) * SEQ + (size_t)(tq & 15) * (SEQ / 16) + (tq >> 4)) * 64 + ch * 8;
                ma[j] = *(const GAS v2u*)((const unsigned char*)O0 + offh); mc[j] = *(const GAS v2u*)((const unsigned char*)O1 + offh); } }
        const float lse2 = mxm8 + __builtin_amdgcn_logf(lsum);
        if (hi == 0) { wsf[r32] = lsum; wsf[32 + r32] = lse2; }
        asm volatile("s_waitcnt lgkmcnt(0)" ::: "memory");
#pragma unroll
        for (int rr = 0; rr < 16; ++rr) { const int orow = crow(rr, hi); const float rl = __builtin_amdgcn_rcpf(wsf[orow]) * (1.0f / 16.f);
#pragma unroll
            for (int d0 = 0; d0 < 2; ++d0) stg[orow * 64 + d0 * 32 + r32] = (bf16)(cvt_pk_bf16(o[d0][rr] * rl, 0.f) & 0xffffu); }
        asm volatile("s_waitcnt lgkmcnt(0)" ::: "memory");
        if constexpr (!MERGE) { if (hi == 0) { const int tq = (I0 + 32 * wid + r32) * dil + r; lse_out[(size_t)(b * 16 + h) * SEQ + (size_t)(tq & 15) * (SEQ / 16) + (tq >> 4)] = lse2; } }
#pragma unroll
        for (int j = 0; j < 4; ++j) { const int row = j * 8 + (lane >> 3), ch = lane & 7;
            const int tq = (I0 + 32 * wid + row) * dil + r; const size_t tok = rowbase + (size_t)tq; const size_t off = tok * D + h * 64 + ch * 8;
            const size_t idh = (size_t)(b * 16 + h) * SEQ + (size_t)(tq & 15) * (SEQ / 16) + (tq >> 4), offh = idh * 64 + ch * 8;
            v4u v = *(const LAS v4u*)(stg + row * 64 + ch * 8);
            if constexpr (MERGE) {
                const float l2 = wsf[32 + row], l0 = ml0[j], l1 = ml1[j];
                const float mm = fmaxf(fmaxf(l0, l1), l2); float w0 = __builtin_amdgcn_exp2f(l0 - mm), w1 = __builtin_amdgcn_exp2f(l1 - mm), w2 = __builtin_amdgcn_exp2f(l2 - mm);
                const float inv = __builtin_amdgcn_rcpf(w0 + w1 + w2); w0 *= inv; w1 *= inv; w2 *= inv;
                const v2u a = ma[j], c = mc[j];
                float mv[8];
#pragma unroll
                for (int e = 0; e < 4; e += 2) {
                    const auto pa0 = __builtin_amdgcn_cvt_pk_f32_fp8((int)a[e >> 1], false), pa1 = __builtin_amdgcn_cvt_pk_f32_fp8((int)a[e >> 1], true);
                    const auto pc0 = __builtin_amdgcn_cvt_pk_f32_fp8((int)c[e >> 1], false), pc1 = __builtin_amdgcn_cvt_pk_f32_fp8((int)c[e >> 1], true);
                    mv[2 * e] = w0 * pa0[0] + w1 * pc0[0] + w2 * SO8 * bf_lo(v[e]); mv[2 * e + 1] = w0 * pa0[1] + w1 * pc0[1] + w2 * SO8 * bf_hi(v[e]);
                    mv[2 * e + 2] = w0 * pa1[0] + w1 * pc1[0] + w2 * SO8 * bf_lo(v[e + 1]); mv[2 * e + 3] = w0 * pa1[1] + w1 * pc1[1] + w2 * SO8 * bf_hi(v[e + 1]); }
                v2u m; m.x = pk4_fp8(mv[0], mv[1], mv[2], mv[3]); m.y = pk4_fp8(mv[4], mv[5], mv[6], mv[7]);
                *(GAS v2u*)((unsigned char*)O + off) = m;
            } else { v2u o8; o8.x = pk4_fp8(bf_lo(v[0]) * SO8, bf_hi(v[0]) * SO8, bf_lo(v[1]) * SO8, bf_hi(v[1]) * SO8); o8.y = pk4_fp8(bf_lo(v[2]) * SO8, bf_hi(v[2]) * SO8, bf_lo(v[3]) * SO8, bf_hi(v[3]) * SO8);
                *(GAS v2u*)((unsigned char*)O + offh) = o8; } }
        asm volatile("s_waitcnt lgkmcnt(0)" ::: "memory");
        __builtin_amdgcn_s_barrier();
        asm volatile("" ::: "memory");
        u = nu;
    }
}
}

__device__ __forceinline__ void moe_slots_scatter(Frame& F) {
    const int gw = F.vcu * NWAVES + F.wave, NGW = F.G * NWAVES;
    int tp[9]; moe_tiles(F, tp);
    { int* slot_tok = (int*)(F.ws + WS_ROUTE + ROUTE_ST);
      for (int t = blockIdx.x * NTHREADS + F.tid; t < M; t += F.G * NTHREADS) { const int4 ri = *(const int4*)(F.ws + WS_ROUTE + ROUTE_I + (size_t)t * 16);
          int o1 = 0, o2 = 0;
#pragma unroll
          for (int e = 0; e < 8; ++e) { if (ri.x == e) o1 = tp[e]; if (ri.y == e) o2 = tp[e]; }
          slot_tok[o1 * 256 + ri.z] = t * 2; slot_tok[o2 * 256 + ri.w] = t * 2 + 1; } }
    { const unsigned char* xq = (const unsigned char*)(F.ws + WS_X3Q); unsigned char* xg = (unsigned char*)(F.ws + WS_XG);
      for (int t0 = gw * 4; t0 < M; t0 += NGW * 4) { v4u a[4]; int s1[4], s2[4];
#pragma unroll
          for (int j = 0; j < 4; ++j) { const int4 ri = *(const int4*)(F.ws + WS_ROUTE + ROUTE_I + (size_t)(t0 + j) * 16); int o1 = 0, o2 = 0;
#pragma unroll
              for (int e = 0; e < 8; ++e) { if (ri.x == e) o1 = tp[e]; if (ri.y == e) o2 = tp[e]; }
              s1[j] = o1 * 256 + ri.z; s2[j] = o2 * 256 + ri.w; a[j] = *(const GAS v4u*)(xq + (size_t)(t0 + j) * D + F.lane * 16); }
#pragma unroll
          for (int j = 0; j < 4; ++j) { *(GAS v4u*)(xg + (size_t)s1[j] * D + F.lane * 16) = a[j]; *(GAS v4u*)(xg + (size_t)s2[j] * D + F.lane * 16) = a[j]; } } }
}
__device__ __forceinline__ void moe_gather(Frame& F, int lo, int hi) {
    const int gw = F.vcu * NWAVES + F.wave, NGW = F.G * NWAVES;
    const int* slot_tok = (const int*)(F.ws + WS_ROUTE + ROUTE_ST); const unsigned char* xq = (const unsigned char*)(F.ws + WS_X3Q); unsigned char* xg = (unsigned char*)(F.ws + WS_XG);
    const int n = (hi - lo) * 256;
    for (int s0 = gw * 4; s0 < n; s0 += NGW * 4) {
        int st[4]; v4u a[4];
#pragma unroll
        for (int j = 0; j < 4; ++j) st[j] = (s0 + j < n) ? slot_tok[lo * 256 + s0 + j] : -1;
#pragma unroll
        for (int j = 0; j < 4; ++j) { a[j] = (v4u){0u, 0u, 0u, 0u}; if (st[j] >= 0) a[j] = *(const GAS v4u*)(xq + (size_t)(st[j] >> 1) * D + F.lane * 16); }
#pragma unroll
        for (int j = 0; j < 4; ++j) if (s0 + j < n) *(GAS v4u*)(xg + (size_t)(s0 + j) * D + F.lane * 16) = a[j]; }
}
__device__ __forceinline__ void final_late_row(const bf16* part, int slot, int lane, f32x4 (&y)[4]) {
    const int rt = slot >> 8, sr = slot & 255;
#pragma unroll
    for (int j = 0; j < 4; ++j) { f32x4 a = {0.f, 0.f, 0.f, 0.f};
#pragma unroll
        for (int ck = 0; ck < 7; ++ck) { const v2u w = *(const GAS v2u*)(part + ((size_t)(((rt - 256) * 4 + j) * 7 + ck) << 16) + (size_t)sr * 256 + lane * 4);
            a += (f32x4){pg8::bf_lo(w.x), pg8::bf_hi(w.x), pg8::bf_lo(w.y), pg8::bf_hi(w.y)}; }
        y[j] = a; }
}
__device__ __forceinline__ void final_pass(Frame& F, float* out, const float* gam, const float* bet) {
    const int gw = F.vcu * NWAVES + F.wave, NGW = F.G * NWAVES;
    f32x4 gv[4], bv[4];
#pragma unroll
    for (int j = 0; j < 4; ++j) { gv[j] = *(const GAS f32x4*)(gam + F.lane * 4 + 256 * j); bv[j] = *(const GAS f32x4*)(bet + F.lane * 4 + 256 * j); }
    const bf16* xb = (const bf16*)(F.ws + WS_X3B);
    int tp[9]; moe_tiles(F, tp);
    const bf16* part = (const bf16*)(F.ws + WS_XG);
    for (int row0 = gw; row0 < M; row0 += 2 * NGW) {
        v2u xw[2][4], y1[2][4], y2[2][4]; float2 rg[2]; int4 ri[2];
#pragma unroll
        for (int t = 0; t < 2; ++t) { const int row = row0 + t * NGW; if (row < M) {
            rg[t] = *(const float2*)(F.ws + WS_ROUTE + ROUTE_G + (size_t)row * 8); ri[t] = *(const int4*)(F.ws + WS_ROUTE + ROUTE_I + (size_t)row * 16);
            const bf16* yrow = (const bf16*)(out + (size_t)row * D);
#pragma unroll
            for (int j = 0; j < 4; ++j) { xw[t][j] = *(const GAS v2u*)(xb + (size_t)row * D + F.lane * 4 + 256 * j); y1[t][j] = *(const GAS v2u*)(yrow + F.lane * 4 + 256 * j); y2[t][j] = *(const GAS v2u*)(yrow + D + F.lane * 4 + 256 * j); } } }
#pragma unroll
        for (int t = 0; t < 2; ++t) { const int row = row0 + t * NGW; if (row < M) {
            f32x4 v[4], ya[4], yb[4];
#pragma unroll
            for (int j = 0; j < 4; ++j) { ya[j] = (f32x4){bf_lo(y1[t][j].x), bf_hi(y1[t][j].x), bf_lo(y1[t][j].y), bf_hi(y1[t][j].y)}; yb[j] = (f32x4){bf_lo(y2[t][j].x), bf_hi(y2[t][j].x), bf_lo(y2[t][j].y), bf_hi(y2[t][j].y)}; }
            { int o1 = 0, o2 = 0;
#pragma unroll
              for (int e = 0; e < 8; ++e) { if (ri[t].x == e) o1 = tp[e]; if (ri[t].y == e) o2 = tp[e]; }
              const int sl1 = __builtin_amdgcn_readfirstlane(o1 * 256 + ri[t].z), sl2 = __builtin_amdgcn_readfirstlane(o2 * 256 + ri[t].w);
              if (sl1 >= 65536) final_late_row(part, sl1, F.lane, ya);
              if (sl2 >= 65536) final_late_row(part, sl2, F.lane, yb); }
#pragma unroll
            for (int j = 0; j < 4; ++j) {
                const f32x4 xf = {bf_lo(xw[t][j].x), bf_hi(xw[t][j].x), bf_lo(xw[t][j].y), bf_hi(xw[t][j].y)};
                v[j] = ALPHA * xf + rg[t].x * ya[j] + rg[t].y * yb[j]; }
            float mean, rstd; ln_stats(v, mean, rstd);
#pragma unroll
            for (int j = 0; j < 4; ++j) { const f32x4 y = (v[j] - mean) * rstd * gv[j] + bv[j]; *(GAS f32x4*)(out + (size_t)row * D + F.lane * 4 + 256 * j) = y; } } }
    }
}

template <int GI> __device__ __forceinline__ void phase_att(Frame& F) {
    const bf16* Qp = (const bf16*)(F.ws + WS_Q); const bf16* Kp = (const bf16*)(F.ws + WS_K); const bf16* Vp = (const bf16*)(F.ws + WS_V);
    const bf16* O0 = (const bf16*)(F.ws + WS_O0); const bf16* O1 = (const bf16*)(F.ws + WS_O1); float* L0 = (float*)(F.ws + WS_LSE); float* L1 = L0 + (size_t)M * 16;
    if constexpr (GI < 2) att::attn_phase<false>(F, GI, Qp, Kp, Vp, (bf16*)(F.ws + (GI == 0 ? WS_O0 : WS_O1)), GI == 0 ? L0 : L1, O0, O1, L0, L1);
    else att::attn_phase<true>(F, GI, Qp, Kp, Vp, (bf16*)(F.ws + WS_MQ), nullptr, O0, O1, L0, L1);
}
template <int RR> __device__ __forceinline__ void moe_round(const Frame& F, int (&tp)[9], int& rlo, int& rhi) {
    moe_tiles(F, tp); rlo = 0; rhi = tp[8];
}
constexpr int ULIST_OFF = LDSCTL_OFF + 256, ULIST_MAX = 1024;
__device__ __forceinline__ int build_unit_list(Frame& F, const int (&tp)[9], int rlo, int rhi, int nN) {
    const int ntot = (rhi - rlo) * nN; const int c = (int)blockIdx.x;
    int n = c < ntot ? (ntot - c + F.G - 1) / F.G : 0; n = n > ULIST_MAX ? ULIST_MAX : n;
    LAS unsigned* list = (LAS unsigned*)(F.lds + ULIST_OFF);
    for (int i = F.tid; i < n; i += NTHREADS) list[i] = pg8::grouped_unit(tp, rlo, rhi, nN, (long)i * F.G + c);
    __syncthreads();
    return __builtin_amdgcn_readfirstlane(n);
}
template <int RR> __device__ __forceinline__ void phase_moe_gather(Frame& F) { int tp[9], rlo, rhi; moe_round<RR>(F, tp, rlo, rhi); moe_gather(F, rlo, rhi); }
template <int RR> __device__ __forceinline__ void phase_moe1(Frame& F) {
    int tp[9], rlo, rhi; moe_round<RR>(F, tp, rlo, rhi);
    const int n = build_unit_list(F, tp, rlo, rhi, 2 * DFE / 256);
    pg8::Gemm g{(const bf16*)(F.ws + WS_XG), (const bf16*)(F.ws + WM_13), 0, 0, D / 2}; pg8::ListOrder S{(const LAS unsigned*)(F.lds + ULIST_OFF), n};
    pg8::EpiSwiGLU8 E{(unsigned char*)(F.ws + WS_H), DFE, 2 * DFE / 256, 1.0f / (SX8 * SW13_8), SH8};
    pg8::gemm_phase<pg8::EpiSwiGLU8, pg8::ListOrder, true, true, true>(F.lds, g, S, E);
}
constexpr int MOE2_KCH = 4, MOE2_NCH = 7;
static_assert(MOE2_KCH * MOE2_NCH * 128 == DFE && (MAXTILES - 256) * 4 * MOE2_NCH <= 256, "MoE-2 K chunks");
template <int RR> __device__ __forceinline__ void phase_moe2(Frame& F, float* out) {
    int tp[9]; moe_tiles(F, tp);
    const int T = tp[8], nmain = (T < 256 ? T : 256) * (D / 256), c = (int)blockIdx.x;
    LAS unsigned* list = (LAS unsigned*)(F.lds + ULIST_OFF);
    int n = c < nmain ? (nmain - c + F.G - 1) / F.G : 0;
    for (int i = F.tid; i < n; i += NTHREADS) list[i] = pg8::grouped_unit(tp, 0, T < 256 ? T : 256, D / 256, (long)i * F.G + c);
    const int ntail = (T > 256 ? T - 256 : 0) * (D / 256);
    if (c < ntail * MOE2_NCH) { const int tu = c / MOE2_NCH, ck = c % MOE2_NCH, rt = 256 + (tu >> 2), ct = tu & 3; int e = 0;
#pragma unroll
        for (int q = 1; q < 8; ++q) if (rt >= tp[q]) e = q;
        if (F.tid == 0) list[n] = (unsigned)rt | ((unsigned)(e * (D / 256) + ct) << 16) | ((unsigned)(ck + 1) << 24);
        ++n; }
    __syncthreads();
    n = __builtin_amdgcn_readfirstlane(n);
    pg8::Gemm g{(const bf16*)(F.ws + WS_H), (const bf16*)(F.ws + WM_2), 0, 0, DFE / 2}; pg8::ListOrder S{(const LAS unsigned*)(F.lds + ULIST_OFF), n};
    pg8::EpiMoE2 E{(bf16*)out, (const int*)(F.ws + WS_ROUTE + ROUTE_ST), D / 256, 1.0f / (SH8 * SW2_8), (bf16*)(F.ws + WS_XG)};
    pg8::gemm_phase<pg8::EpiMoE2, pg8::ListOrder, true, true, true, MOE2_KCH>(F.lds, g, S, E);
}

template <int K> __device__ __forceinline__ void run_phase(Frame& F, float* out_) {
    bf16* const xb0 = (bf16*)(F.ws + WS_XB0); bf16* const x1b = (bf16*)(F.ws + WS_X1B); bf16* const x2b = (bf16*)(F.ws + WS_X2B); bf16* const x3b = (bf16*)(F.ws + WS_X3B);
    bf16* const Z = (bf16*)(F.ws + WS_Z); bf16* const Z2 = (bf16*)(F.ws + WS_Z2); bf16* const Z2B = (bf16*)(F.ws + WS_Z2B);
    pg8::stat_t* const ST1 = (pg8::stat_t*)(F.ws + WS_ST); pg8::stat_t* const ST2 = ST1 + (size_t)M;
    float* const cv13 = (float*)(F.ws + WS_TAB + TAB_CV13); float* const dv13 = cv13 + 2 * DFF; float* const cvq = (float*)(F.ws + WS_TAB + TAB_CVQKV); float* const dvq = cvq + 9 * D;
    if constexpr (K == 0) p0_prologue<0>(F);
    else if constexpr (K == 1) {
        pg8::Gemm g{xb0, (const bf16*)(F.ws + W_IN), M, D, D / 2}; pg8::StaticOrder S; S.init(M, D, F.G, (int)blockIdx.x);
        pg8::EpiU E{(bf16*)(F.ws + WS_U), 1.0f / (SX8 * SWI8)};
        pg8::gemm_phase<pg8::EpiU, pg8::StaticOrder, true, true, true>(F.lds, g, S, E);
    } else if constexpr (K == 2) {
        s5_phase<false>(F); }
    else if constexpr (K == 3) s5_phase<true>(F);
    else if constexpr (K == 4) {
        pg8::Gemm g{(const bf16*)(F.ws + WS_YB), (const bf16*)(F.ws + W_GLU), M, 2 * D, D / 2}; pg8::StaticOrder S; S.init(M, 2 * D, F.G, (int)blockIdx.x);
        pg8::EpiGLU E{INP(0), Z, ALPHA, 1.f, 1.0f / (SY8 * SWG8), ST1};
        pg8::gemm_phase<pg8::EpiGLU, pg8::StaticOrder, true, true, true>(F.lds, g, S, E);
    } else if constexpr (K == 5) { }
    else if constexpr (K == 6) {
        pg8::Gemm g{Z, (const bf16*)(F.ws + W_13), M, 2 * DFF, D}; pg8::StaticOrder S; S.init(M, 2 * DFF, F.G, (int)blockIdx.x);
        pg8::EpiSwiGLUf<FFN_DOWN_FP8 != 0> E{(bf16*)(F.ws + WS_HF), DFF, ST1, cv13, dv13};
        pg8::gemm_phase<pg8::EpiSwiGLUf<FFN_DOWN_FP8 != 0>, pg8::StaticOrder, true, true>(F.lds, g, S, E);
    } else if constexpr (K == 7) {
#if FFN_DOWN_FP8
        pg8::Gemm g{(const bf16*)(F.ws + WS_HF), (const bf16*)(F.ws + W_2), M, D, DFF / 2}; pg8::StaticOrder S; S.init(M, D, F.G, (int)blockIdx.x);
        pg8::EpiResidF E{Z, ST1, INP(21), INP(22), Z2B, (unsigned char*)(F.ws + WS_X2Q), ST2, ALPHA, 1.0f / (8.f * 2048.f)};
        pg8::gemm_phase<pg8::EpiResidF, pg8::StaticOrder, true, true, true>(F.lds, g, S, E);
#else
        pg8::Gemm g{(const bf16*)(F.ws + WS_HF), (const bf16*)(F.ws + W_2), M, D, DFF}; pg8::StaticOrder S; S.init(M, D, F.G, (int)blockIdx.x);
        pg8::EpiResidF E{Z, ST1, INP(21), INP(22), Z2B, (unsigned char*)(F.ws + WS_X2Q), ST2, ALPHA, 1.f};
        pg8::gemm_phase<pg8::EpiResidF, pg8::StaticOrder, true, true>(F.lds, g, S, E);
#endif
    } else if constexpr (K == 8) { }
    else if constexpr (K == 9 || K == 11 || K == 13) {
        constexpr int gi = (K - 9) / 2;
        pg8::Gemm g{(const bf16*)(F.ws + WS_X2Q), (const bf16*)(F.ws + W_QKV + (size_t)gi * 3 * D * D), M, 3 * D, D / 2}; pg8::StaticOrder S; S.init(M, 3 * D, F.G, (int)blockIdx.x);
        pg8::EpiQKV E{(bf16*)(F.ws + WS_Q), (size_t)(WS_K - WS_Q) / 2, 1.0f / (SX8 * SWQ8), ST2, cvq + gi * 3 * D, dvq + gi * 3 * D, 2 * gi};
        pg8::gemm_phase<pg8::EpiQKV, pg8::StaticOrder, true, true, true>(F.lds, g, S, E);
    } else if constexpr (K == 10 || K == 12 || K == 14) phase_att<(K - 10) / 2>(F);
    else if constexpr (K == 15) {
        pg8::Gemm g{(const bf16*)(F.ws + WS_MQ), (const bf16*)(F.ws + W_O), M, D, D / 2}; pg8::StaticOrder S; S.init(M, D, F.G, (int)blockIdx.x);
        pg8::EpiResidF E{Z2B, ST2, INP(21) + D, INP(22) + D, Z2, nullptr, nullptr, ALPHA, 1.0f / (SO8 * SWO8)};
        pg8::gemm_phase<pg8::EpiResidF, pg8::StaticOrder, true, true, true>(F.lds, g, S, E);
    } else if constexpr (K == 16) ln_router_pass(F, Z2, INP(21) + 2 * D, INP(22) + 2 * D, INP(17), x3b, (unsigned char*)(F.ws + WS_X3Q));
    else if constexpr (K == 17) moe_slots_scatter(F);
    else if constexpr (K == 18) { }
    else if constexpr (K == 19) phase_moe1<0>(F);
    else if constexpr (K == 20) phase_moe2<0>(F, out_);
    else if constexpr (K == 21) final_pass(F, out_, INP(21) + 3 * D, INP(22) + 3 * D);
}

template <int K> __device__ __forceinline__ void seam_work(Frame& F) {
    LAS float* scr = (LAS float*)(F.lds + F.wave * TR_SCR_BYTES);
    const int gw = F.vcu * NWAVES + F.wave, NGW = F.G * NWAVES;
    int cur = 0;
    float* const cv13 = (float*)(F.ws + WS_TAB + TAB_CV13); float* const dv13 = cv13 + 2 * DFF; float* const cvq = (float*)(F.ws + WS_TAB + TAB_CVQKV); float* const dvq = cvq + 9 * D;
    auto moe_w2 = [&](int e) { transpose_matrix<true>(INP(20) + (size_t)e * DFE * D, DFE, D, D, (void*)(F.ws + WM_2 + (size_t)e * D * DFE), 0, 0, SW2_8, nullptr, scr, F.lane, gw, NGW, cur); };
    auto moe_w1 = [&](int e) { transpose_matrix<true>(INP(18) + (size_t)e * D * DFE, D, DFE, DFE, (void*)(F.ws + WM_13 + (size_t)e * 2 * DFE * D), 1, 0, SW13_8, nullptr, scr, F.lane, gw, NGW, cur); };
    auto moe_w3 = [&](int e) { transpose_matrix<true>(INP(19) + (size_t)e * D * DFE, D, DFE, DFE, (void*)(F.ws + WM_13 + (size_t)e * 2 * DFE * D), 1, 1, SW13_8, nullptr, scr, F.lane, gw, NGW, cur); };
    auto wqkv = [&](int g) { transpose_matrix<true>(INP(11) + g * 3 * D, D, 3 * D, 9 * D, (void*)(F.ws + W_QKV + (size_t)g * 3 * D * D), 2, 0, SWQ8, INP(21) + D, scr, F.lane, gw, NGW, cur); };
    if constexpr (K == 0) p0_prologue<1>(F);
    else if constexpr (K == 1) {
        transpose_matrix(INP(14), D, DFF, DFF, (bf16*)(F.ws + W_13), 1, 0, 1.0f, INP(21), scr, F.lane, gw, NGW, cur);
        transpose_matrix(INP(15), D, DFF, DFF, (bf16*)(F.ws + W_13), 1, 1, 1.0f, INP(21), scr, F.lane, gw, NGW, cur); }
    else if constexpr (K == 2) { wqkv(0); wqkv(1); }
    else if constexpr (K == 3) { wqkv(2); colvec_pass<false>(F, (const void*)(F.ws + W_13), 2 * DFF, 1.0f, INP(21), INP(22), cv13, dv13); }
    else if constexpr (K == 4) {
#if FFN_DOWN_FP8
        transpose_matrix<true>(INP(16), DFF, D, D, (void*)(F.ws + W_2), 0, 0, 2048.f, nullptr, scr, F.lane, gw, NGW, cur);
#else
        transpose_matrix(INP(16), DFF, D, D, (bf16*)(F.ws + W_2), 0, 0, 1.0f, nullptr, scr, F.lane, gw, NGW, cur);
#endif
        transpose_matrix<true>(INP(12), D, D, D, (void*)(F.ws + W_O), 0, 0, SWO8, nullptr, scr, F.lane, gw, NGW, cur); }
    else if constexpr (K == 6) colvec_pass<true>(F, (const void*)(F.ws + W_QKV), 9 * D, 1.0f / SWQ8, INP(21) + D, INP(22) + D, cvq, dvq);
    else if constexpr (K == 7) { moe_w2(0); moe_w1(0); }
    else if constexpr (K == 9) { moe_w2(1); moe_w3(0); }
    else if constexpr (K == 10) { moe_w2(2); moe_w1(1); }
    else if constexpr (K == 11) { moe_w2(3); moe_w3(1); }
    else if constexpr (K == 12) { moe_w2(4); moe_w1(2); }
    else if constexpr (K == 13) { moe_w2(5); moe_w3(2); moe_w1(3); }
    else if constexpr (K == 14) { moe_w2(6); moe_w3(3); moe_w1(4); moe_w3(4); }
    else if constexpr (K == 15) { moe_w1(5); moe_w3(5); moe_w1(6); }
    else if constexpr (K == 16) { moe_w3(6); moe_w1(7); moe_w3(7); }
    else if constexpr (K == 17) moe_w2(7);
}

struct Args { In in; float* out; unsigned char* ws; int ph_lo, ph_hi; };
__global__ void __launch_bounds__(NTHREADS, 2) mk_fwd(Args args) {
    extern __shared__ __attribute__((aligned(16))) unsigned char lds_raw[];
    Frame F;
    F.lds = (LAS unsigned char*)lds_raw; F.ws = args.ws; float* const out_ = args.out;
    F.tid = threadIdx.x; F.lane = F.tid & 63; F.wave = __builtin_amdgcn_readfirstlane(F.tid >> 6);
    F.G = gridDim.x; { const int bx = blockIdx.x; F.vcu = (F.G % 8 == 0) ? (bx % 8) * (F.G / 8) + bx / 8 : bx; }
    for (int u = F.tid; u < (LDS_BYTES - LDSCTL_OFF) / 4; u += NTHREADS) ((LAS unsigned*)(F.lds + LDSCTL_OFF))[u] = 0u;
    __syncthreads();
    unsigned* ctl = (unsigned*)(F.ws + WS_CTL);
    XcdBarrier bar; bar.bar = ctl + CW_BAR; bar.x = 0; bar.st = nullptr;
#if !MK_SPLIT
    bar = xcd_barrier_post(ctl + CW_BAR, (volatile LAS unsigned*)(F.lds + LDSCTL_OFF));
#endif
    const int lo = args.ph_lo, hi = args.ph_hi;
#ifndef PH_MASK
#define PH_MASK 0x3fffffu
#endif
#define IN(k) (((PH_MASK >> (k)) & 1u) && lo <= (k) && (k) < hi)
#if MK_SPLIT
#define SEAM(k) do { } while (0)
#else
#define SEAM(k) do { if ((k) + 1 < hi) xcd_barrier(bar); } while (0)
#endif
#define RUN(k) if (IN(k)) { run_phase<k>(F, out_); SEAM(k); }
#if MK_SPLIT
#define RUNW(k) if (IN(k)) { run_phase<k>(F, out_); seam_work<k>(F); }
#else
#define RUNW(k) if (IN(k)) { run_phase<k>(F, out_); xcd_barrier_arrive(bar); seam_work<k>(F); xcd_barrier_wait(bar); }
#endif
    RUNW(0) RUNW(1) RUNW(2) RUNW(3) RUNW(4) RUNW(6) RUNW(7) RUNW(9) RUNW(10) RUNW(11) RUNW(12) RUNW(13) RUNW(14) RUNW(15) RUNW(16) RUNW(17) RUN(19) RUN(20)
    if (IN(21)) { run_phase<21>(F, out_); }
#undef RUN
#undef RUNW
#undef IN
#undef SEAM
}

extern "C" void kernel_launch(void* const* d_in, const int* in_sizes, int n_in, void* d_out, int out_size, void* d_ws, size_t ws_size, hipStream_t stream) {
    static int grid = 0;
    if (grid == 0) {
        if (n_in != 23 || in_sizes[0] != M * D || out_size != M * D || ws_size < WS_END) { fprintf(stderr, "kernel_launch: unexpected shapes / workspace (n_in %d, in0 %d, out %d, ws %zu, need %zu)\n", n_in, n_in > 0 ? in_sizes[0] : -1, out_size, ws_size, (size_t)WS_END); grid = -1; return; }
        int dev = 0, cus = 0, per_cu = 0;
        if (hipGetDevice(&dev) != hipSuccess || hipDeviceGetAttribute(&cus, hipDeviceAttributeMultiprocessorCount, dev) != hipSuccess) { grid = -1; return; }
        if (hipFuncSetAttribute((const void*)mk_fwd, hipFuncAttributeMaxDynamicSharedMemorySize, LDS_BYTES) != hipSuccess) { fprintf(stderr, "kernel_launch: hipFuncSetAttribute failed\n"); grid = -1; return; }
        if (hipOccupancyMaxActiveBlocksPerMultiprocessor(&per_cu, (const void*)mk_fwd, NTHREADS, LDS_BYTES) != hipSuccess || per_cu < 1) fprintf(stderr, "kernel_launch: occupancy query says %d\n", per_cu);
        (void)hipGetLastError();
        grid = cus;
        if (grid != 256) { fprintf(stderr, "kernel_launch: built for 256 CUs, device has %d\n", cus); grid = -1; return; }
    }
    if (grid < 0) return;
    if (hipMemsetAsync((char*)d_ws + WS_CTL, 0, CTL_ZERO_BYTES, stream) != hipSuccess) return;
    if (hipMemsetAsync((char*)d_ws + WS_ST, 0, ST_BYTES, stream) != hipSuccess) return;
    Args a{};
    for (int i = 0; i < 23; ++i) a.in.p[i] = (const float*)d_in[i];
    a.out = (float*)d_out; a.ws = (unsigned char*)d_ws;
#if MK_SPLIT
    for (int p = 0; p < NPHASE; ++p) { a.ph_lo = p; a.ph_hi = p + 1; hipLaunchKernelGGL(mk_fwd, dim3(grid), dim3(NTHREADS), LDS_BYTES, stream, a); }
#else
    a.ph_lo = 0; a.ph_hi = NPHASE;
    hipLaunchKernelGGL(mk_fwd, dim3(grid), dim3(NTHREADS), LDS_BYTES, stream, a);
#endif
}
```
